# Optimizing an MI355X kernel written in HIP

```python
import math
import jax, jax.numpy as jnp
from jax import lax
import numpy as np

D_MODEL = 1024
BATCH = 4
SEQ = 4096
DEPTH = 1

MEM_LEN = 256
EPS = 1e-6

GDN_HEADS = 8
GDN_DK = 128
GDN_DV = 128
GDN_QK = GDN_HEADS * GDN_DK
GDN_V = GDN_HEADS * GDN_DV
CONV_WIDTH = 4
CHUNK = 64

DIFF_HEADS = 8
DIFF_DH = 64
DIFF_QK = DIFF_HEADS * 2 * DIFF_DH
DIFF_V = DIFF_HEADS * 2 * DIFF_DH
ROPE_DIM = DIFF_DH // 4
ROPE_THETA = 500000.0
Q_BLOCK = 128

X_HEADS = 4
X_DH = 128
X_W = X_HEADS * X_DH

D_FF = -(-8 * D_MODEL // (3 * 256)) * 256

IN_SIZES = [2 * GDN_QK + GDN_V, GDN_V, GDN_HEADS, GDN_HEADS, DIFF_QK, DIFF_QK, DIFF_V]
IN_SPLITS = [int(s) for s in np.cumsum(IN_SIZES)[:-1]]
IN_TOTAL = int(sum(IN_SIZES))

kernel_name = "hybrid_gdn_diffattn_gated_merge"


def rmsnorm(x, g):
    xf = x.astype(jnp.float32)
    out = xf * lax.rsqrt(jnp.mean(xf * xf, axis=-1, keepdims=True) + EPS) * g.astype(jnp.float32)
    return out.astype(x.dtype)


def l2norm(x):
    return x * lax.rsqrt(jnp.sum(x * x, axis=-1, keepdims=True) + EPS)


def partial_rope(x, positions):
    half = ROPE_DIM // 2
    inv_freq = ROPE_THETA ** (-jnp.arange(0, ROPE_DIM, 2, dtype=jnp.float32) / ROPE_DIM)
    ang = positions.astype(jnp.float32)[..., None] * inv_freq
    cos = jnp.cos(ang)[:, :, None, :]
    sin = jnp.sin(ang)[:, :, None, :]
    xf = x.astype(jnp.float32)
    x1, x2, rest = xf[..., :half], xf[..., half:ROPE_DIM], xf[..., ROPE_DIM:]
    out = jnp.concatenate([x1 * cos - x2 * sin, x2 * cos + x1 * sin, rest], axis=-1)
    return out.astype(x.dtype)


def causal_depthwise_conv(x, w):
    S = x.shape[1]
    xp = jnp.pad(x, ((0, 0), (CONV_WIDTH - 1, 0), (0, 0)))
    out = xp[:, 0:S] * w[0]
    for j in range(1, CONV_WIDTH):
        out = out + xp[:, j:j + S] * w[j]
    return out


def gated_delta_rule(q, k, v, g, beta):
    B, S, H, DK = q.shape
    DV = v.shape[-1]
    N = S // CHUNK
    f32 = jnp.float32
    q = l2norm(q.astype(f32)) * (DK ** -0.5)
    k = l2norm(k.astype(f32))
    v = v.astype(f32)

    def chunks(t):
        t = t.reshape((B, N, CHUNK, H) + t.shape[3:])
        return jnp.moveaxis(t, 3, 1)

    q, k, v = chunks(q), chunks(k), chunks(v)
    g = jnp.cumsum(chunks(g.astype(f32)), axis=-1)
    beta = chunks(beta.astype(f32))
    kb = k * beta[..., None]
    vb = v * beta[..., None]

    idx = jnp.arange(CHUNK)
    incl = idx[:, None] >= idx[None, :]
    strict = idx[:, None] > idx[None, :]
    gdiff = g[..., :, None] - g[..., None, :]
    decay = jnp.where(incl, jnp.exp(jnp.where(incl, gdiff, 0.0)), 0.0)
    L = jnp.where(strict, jnp.einsum('bhncd,bhnmd->bhncm', kb, k) * decay, 0.0)
    eye = jnp.eye(CHUNK, dtype=f32)
    T = lax.linalg.triangular_solve(L + eye, jnp.broadcast_to(eye, L.shape),
                                    left_side=True, lower=True)
    u = T @ vb
    w = T @ (kb * jnp.exp(g)[..., None])
    attn = jnp.einsum('bhncd,bhnmd->bhncm', q, k) * decay
    g_last = g[..., -1]
    k_dec = k * jnp.exp(g_last[..., None] - g)[..., None]
    q_dec = q * jnp.exp(g)[..., None]

    def step(state, inp):
        u_i, w_i, q_i, k_i, a_i, gl_i = inp
        v_new = u_i - jnp.einsum('bhcd,bhde->bhce', w_i, state)
        o_i = (jnp.einsum('bhcd,bhde->bhce', q_i, state)
               + jnp.einsum('bhcm,bhme->bhce', a_i, v_new))
        state = (state * jnp.exp(gl_i)[..., None, None]
                 + jnp.einsum('bhcd,bhce->bhde', k_i, v_new))
        return state, o_i

    s0 = jnp.zeros((B, H, DK, DV), f32)
    xs = tuple(jnp.moveaxis(t, 2, 0) for t in (u, w, q_dec, k_dec, attn, g_last))
    _, o = lax.scan(step, s0, xs)
    return jnp.transpose(o, (1, 0, 3, 2, 4)).reshape(B, S, H, DV)


def differential_attention(q, k, v, lam):
    B, S, H, _, DH = q.shape
    nb = S // Q_BLOCK
    f32 = jnp.float32
    qb = jnp.moveaxis(q.reshape(B, nb, Q_BLOCK, H, 2, DH), 1, 0)
    starts = jnp.arange(nb, dtype=jnp.int32) * Q_BLOCK
    kf = k.astype(f32)
    vf = v.astype(f32)
    key_idx = jnp.arange(S, dtype=jnp.int32)

    def one_block(args):
        q_blk, start = args
        s = jnp.einsum('bqhmd,bkhmd->bhmqk', q_blk.astype(f32), kf)
        q_idx = start + jnp.arange(Q_BLOCK, dtype=jnp.int32)
        mask = q_idx[:, None] >= key_idx[None, :]
        p = jax.nn.softmax(jnp.where(mask, s, -jnp.inf), axis=-1)
        a = p[:, :, 0] - lam * p[:, :, 1]
        return jnp.einsum('bhqk,bkhe->bqhe', a, vf)

    o = lax.map(one_block, (qb, starts))
    return jnp.moveaxis(o, 0, 1).reshape(B, S, H, 2 * DH)


def setup_inputs(seed: int = 0) -> dict:
    key = jax.random.key(seed)
    ks = jax.random.split(key, 32)
    f32 = jnp.float32

    def nrm(k, shape, fan_in):
        return jax.random.normal(k, shape, f32) * (fan_in ** -0.5)

    def gain(k, shape):
        return 1.0 + 0.01 * jax.random.normal(k, shape, f32)

    x = jax.random.normal(ks[0], (BATCH, SEQ, D_MODEL), f32)
    mem = jax.random.normal(ks[1], (BATCH, MEM_LEN, D_MODEL), f32)
    offs = jax.random.randint(ks[2], (BATCH, 1), 0, 1024, dtype=jnp.int32)
    positions = (jnp.arange(SEQ, dtype=jnp.int32)[None, :] + offs).astype(jnp.int32)

    dt = jnp.exp(jax.random.uniform(ks[6], (DEPTH, GDN_HEADS), f32,
                                    math.log(0.001), math.log(0.1)))
    dt_bias = dt + jnp.log(-jnp.expm1(-dt))
    a_log = jnp.log(jax.random.uniform(ks[5], (DEPTH, GDN_HEADS), f32, 1.0, 16.0))

    return {
        "x": x,
        "mem": mem,
        "positions": positions,
        "g_mix": gain(ks[3], (DEPTH, D_MODEL)),
        "w_in": nrm(ks[4], (DEPTH, D_MODEL, IN_TOTAL), D_MODEL),
        "conv_w": nrm(ks[7], (DEPTH, CONV_WIDTH, 2 * GDN_QK + GDN_V), CONV_WIDTH),
        "a_log": a_log,
        "dt_bias": dt_bias,
        "gdn_norm_g": gain(ks[8], (DEPTH, GDN_DV)),
        "lambda_q1": 0.1 * jax.random.normal(ks[9], (DEPTH, DIFF_DH), f32),
        "lambda_k1": 0.1 * jax.random.normal(ks[10], (DEPTH, DIFF_DH), f32),
        "lambda_q2": 0.1 * jax.random.normal(ks[11], (DEPTH, DIFF_DH), f32),
        "lambda_k2": 0.1 * jax.random.normal(ks[12], (DEPTH, DIFF_DH), f32),
        "diff_norm_g": gain(ks[13], (DEPTH, 2 * DIFF_DH)),
        "w_branch_gate": nrm(ks[14], (DEPTH, D_MODEL, 2 * D_MODEL), D_MODEL),
        "w_out_a": nrm(ks[15], (DEPTH, GDN_V, D_MODEL), GDN_V),
        "w_out_b": nrm(ks[16], (DEPTH, DIFF_V, D_MODEL), DIFF_V),
        "w_o": nrm(ks[17], (DEPTH, D_MODEL, D_MODEL), D_MODEL),
        "g_cross": gain(ks[18], (DEPTH, D_MODEL)),
        "g_mem": gain(ks[19], (DEPTH, D_MODEL)),
        "w_cq": nrm(ks[20], (DEPTH, D_MODEL, X_W), D_MODEL),
        "w_ckv": nrm(ks[21], (DEPTH, D_MODEL, 2 * X_W), D_MODEL),
        "w_co": nrm(ks[22], (DEPTH, X_W, D_MODEL), X_W),
        "g_ffn": gain(ks[23], (DEPTH, D_MODEL)),
        "w_ffn_in": nrm(ks[24], (DEPTH, D_MODEL, 2 * D_FF), D_MODEL),
        "w_ffn_out": nrm(ks[25], (DEPTH, D_FF, D_MODEL), D_FF),
        "g_final": gain(ks[26], (D_MODEL,)),
    }


def reference(x, mem, positions, g_mix, w_in, conv_w, a_log, dt_bias, gdn_norm_g,
              lambda_q1, lambda_k1, lambda_q2, lambda_k2, diff_norm_g, w_branch_gate,
              w_out_a, w_out_b, w_o, g_cross, g_mem, w_cq, w_ckv, w_co,
              g_ffn, w_ffn_in, w_ffn_out, g_final):
    B, S, _ = x.shape
    M = mem.shape[1]
    f32 = jnp.float32
    for l in range(DEPTH):
        h = rmsnorm(x, g_mix[l])
        proj = h @ w_in[l]
        qkv_a, z_a, a_a, b_a, q_b, k_b, v_b = jnp.split(proj, IN_SPLITS, axis=-1)

        qkv_a = jax.nn.silu(causal_depthwise_conv(qkv_a, conv_w[l]))
        q_a, k_a, v_a = jnp.split(qkv_a, [GDN_QK, 2 * GDN_QK], axis=-1)
        q_a = q_a.reshape(B, S, GDN_HEADS, GDN_DK)
        k_a = k_a.reshape(B, S, GDN_HEADS, GDN_DK)
        v_a = v_a.reshape(B, S, GDN_HEADS, GDN_DV)
        g_a = -jnp.exp(a_log[l].astype(f32)) * jax.nn.softplus(
            a_a.astype(f32) + dt_bias[l].astype(f32))
        beta_a = jax.nn.sigmoid(b_a.astype(f32))
        o_a = gated_delta_rule(q_a, k_a, v_a, g_a, beta_a)
        o_a = rmsnorm(o_a, gdn_norm_g[l]) * jax.nn.silu(
            z_a.reshape(B, S, GDN_HEADS, GDN_DV).astype(f32))
        o_a = o_a.reshape(B, S, GDN_V).astype(x.dtype)

        lam_init = 0.8 - 0.6 * math.exp(-0.3 * l)
        lam = (jnp.exp(jnp.sum(lambda_q1[l].astype(f32) * lambda_k1[l].astype(f32)))
               - jnp.exp(jnp.sum(lambda_q2[l].astype(f32) * lambda_k2[l].astype(f32)))
               + lam_init)
        qd = partial_rope(q_b.reshape(B, S, DIFF_HEADS * 2, DIFF_DH), positions) * (DIFF_DH ** -0.5)
        kd = partial_rope(k_b.reshape(B, S, DIFF_HEADS * 2, DIFF_DH), positions)
        qd = qd.reshape(B, S, DIFF_HEADS, 2, DIFF_DH)
        kd = kd.reshape(B, S, DIFF_HEADS, 2, DIFF_DH)
        vd = v_b.reshape(B, S, DIFF_HEADS, 2 * DIFF_DH)
        o_b = differential_attention(qd, kd, vd, lam)
        o_b = (rmsnorm(o_b, diff_norm_g[l]) * (1.0 - lam_init)).reshape(B, S, DIFF_V).astype(x.dtype)

        gates = jax.nn.sigmoid(h @ w_branch_gate[l])
        gate_a, gate_b = jnp.split(gates, 2, axis=-1)
        merged = gate_a * (o_a @ w_out_a[l]) + gate_b * (o_b @ w_out_b[l])
        x = x + (merged @ w_o[l]).astype(x.dtype)

        hx = rmsnorm(x, g_cross[l])
        hm = rmsnorm(mem, g_mem[l])
        qc = (hx @ w_cq[l]).reshape(B, S, X_HEADS, X_DH) * (X_DH ** -0.5)
        kc, vc = jnp.split(hm @ w_ckv[l], 2, axis=-1)
        kc = kc.reshape(B, M, X_HEADS, X_DH)
        vc = vc.reshape(B, M, X_HEADS, X_DH)
        sc = jnp.einsum('bshd,bmhd->bhsm', qc.astype(f32), kc.astype(f32))
        pc = jax.nn.softmax(sc, axis=-1)
        oc = jnp.einsum('bhsm,bmhd->bshd', pc, vc.astype(f32)).reshape(B, S, X_W).astype(x.dtype)
        x = x + (oc @ w_co[l]).astype(x.dtype)

        hf = rmsnorm(x, g_ffn[l])
        gf, uf = jnp.split(hf @ w_ffn_in[l], 2, axis=-1)
        x = x + ((jax.nn.silu(gf) * uf) @ w_ffn_out[l]).astype(x.dtype)

    return rmsnorm(x, g_final)
```

```cpp
#include <hip/hip_runtime.h>
#include <hip/hip_bf16.h>
#include <hip/hip_cooperative_groups.h>
#include <cstdio>
#include <cstdint>
#include <cmath>
namespace cg = cooperative_groups;
#ifndef DBG
#define DBG 0
#endif
__device__ __forceinline__ int lane_id() { int x; asm volatile("v_mbcnt_lo_u32_b32 %0, -1, 0\n\tv_mbcnt_hi_u32_b32 %0, -1, %0" : "=v"(x)); return x; }
__device__ __forceinline__ int fresh_s(int v) { asm volatile("" : "+s"(v)); return v; }
namespace pg8 {
#define PG8_LAS __attribute__((address_space(3)))
typedef unsigned short bf16_t;
typedef short bf16x8 __attribute__((ext_vector_type(8)));
typedef float f32x4 __attribute__((ext_vector_type(4)));
typedef unsigned u32x4 __attribute__((ext_vector_type(4)));
constexpr int BM = 256, BK = 64, HALF = 128, HTB = HALF * BK * 2  , STAGE_BYTES = 8 * HTB, NXCD = 8, WGM = 8;

__host__ __device__ __forceinline__ int lds_byte(int r, int c) { const int st = (r >> 4) * 2 + (c >> 5), rr = r & 15, cc = c & 31, ob = rr * 64 + cc * 2; return st * 1024 + (ob ^ (((ob >> 9) & 1) << 5)); }
__host__ __device__ __forceinline__ void stage_rc(int b, int& R, int& C) { const int st = b / 1024, sb = b % 1024, swz = sb ^ (((sb >> 9) & 1) << 5); R = (st >> 1) * 16 + swz / 64; C = (st & 1) * 32 + (swz % 64) / 2; }
__host__ __device__ __forceinline__ int perm32(int rho) { const int n = rho >> 4, i = rho & 15; return 8 * (i >> 2) + 4 * n + (i & 3); }

struct Unit { int pm, pn; };
struct Gemm { const bf16_t* A; const bf16_t* Bt; int M, N, K; int a_split; long a_delta; };

struct StaticOrder {
    int nM, nN, nwg, G, c;
    __host__ __device__ void init(int M, int N, int G_, int c_) { nM = M / BM; nN = N / BM; nwg = nM * nN; G = G_; c = c_; }
    __host__ __device__ bool next(int i, Unit& u) const {
        const long L = (long)i * G + c; if (L >= nwg) return false;
        int wgid = (int)L; { const int q = nwg / NXCD, r = nwg % NXCD, xcd = wgid % NXCD, off = wgid / NXCD; wgid = (xcd < r ? xcd * (q + 1) : r * (q + 1) + (xcd - r) * q) + off; }
        const int nig = WGM * nN, gid = wgid / nig, fm = gid * WGM, gsz = (nM - fm) < WGM ? (nM - fm) : WGM;
        u.pm = fm + ((wgid % nig) % gsz); u.pn = (wgid % nig) / gsz; return true;
    }
    __device__ __forceinline__ void a_ready(const Unit&) const {}
    __device__ __forceinline__ void done(const Unit&) const {}
};

__device__ __forceinline__ unsigned cvt_pk_bf16(float lo, float hi) { unsigned r; asm volatile("v_cvt_pk_bf16_f32 %0, %1, %2" : "=v"(r) : "v"(lo), "v"(hi)); return r; }
typedef float f32x2 __attribute__((ext_vector_type(2)));
typedef float f32x2 __attribute__((ext_vector_type(2)));
typedef unsigned u32x2 __attribute__((ext_vector_type(2)));
__device__ __forceinline__ u32x4 pk8(const f32x4 a, const f32x4 b) { u32x4 w; w.x = cvt_pk_bf16(a[0], a[1]); w.y = cvt_pk_bf16(a[2], a[3]); w.z = cvt_pk_bf16(b[0], b[1]); w.w = cvt_pk_bf16(b[2], b[3]); return w; }
__device__ __forceinline__ float bflo(unsigned u) { return __uint_as_float(u << 16); }
__device__ __forceinline__ float bfhi(unsigned u) { return __uint_as_float(u & 0xffff0000u); }
__device__ __forceinline__ float sigmoidf_(float x) { return 1.0f / (1.0f + __expf(-x)); }
__device__ __forceinline__ float rstd16(const float* ss16) { const f32x4 a = *(const f32x4*)ss16, b = *(const f32x4*)(ss16 + 4), c = *(const f32x4*)(ss16 + 8), d = *(const f32x4*)(ss16 + 12);
    const float s = ((a[0] + a[1]) + (a[2] + a[3])) + ((b[0] + b[1]) + (b[2] + b[3])) + ((c[0] + c[1]) + (c[2] + c[3])) + ((d[0] + d[1]) + (d[2] + d[3])); return 1.0f / sqrtf(s * (1.0f / 1024.0f) + 1e-6f); }

struct EpiP1 {
    static constexpr bool PERM = true, AFTER_DRAIN = false;
    bf16_t *d0, *d1, *d2, *d3, *d4, *d5; const float* rstd; const float* rcos; const float* rsin; float qscale;
    __device__ __forceinline__ void operator()(const f32x4 (&acc)[2][2][4][2], const Unit& u, int wr, int wc, int fr, int fq) const {
        const int grp = u.pn >> 2; bf16_t* base = grp == 0 ? d0 : grp == 1 ? d1 : grp == 2 ? d2 : grp == 3 ? d3 : grp == 4 ? d4 : d5; const int col0 = (u.pn & 3) * BM + wc * 32 + 8 * fq;
        const bool rope = (grp == 3 || grp == 4) && ((wc & 1) == 0); const float sc = (grp == 3) ? qscale : 1.0f;
#pragma unroll
        for (int ai = 0; ai < 2; ++ai)
#pragma unroll
            for (int m = 0; m < 4; ++m) { const int row = u.pm * BM + ai * HALF + wr * 64 + m * 16 + fr; const float rs = rstd[row] * sc;
                f32x4 c0 = {1.f, 1.f, 1.f, 1.f}, c1 = c0, s0 = {0.f, 0.f, 0.f, 0.f}, s1 = s0;
                if (rope) { c0 = *(const f32x4*)(rcos + (size_t)row * 8); c1 = *(const f32x4*)(rcos + (size_t)row * 8 + 4); s0 = *(const f32x4*)(rsin + (size_t)row * 8); s1 = *(const f32x4*)(rsin + (size_t)row * 8 + 4);
                    if (fq >= 2) { c0 = (f32x4){1.f, 1.f, 1.f, 1.f}; c1 = c0; s0 = (f32x4){0.f, 0.f, 0.f, 0.f}; s1 = s0; } else if (fq == 0) { s0 = -s0; s1 = -s1; } }
#pragma unroll
                for (int bj = 0; bj < 2; ++bj) { f32x4 v0 = acc[ai][bj][m][0] * rs, v1 = acc[ai][bj][m][1] * rs;
                    if (rope) { f32x4 p0, p1;
#pragma unroll
                        for (int e = 0; e < 4; ++e) { p0[e] = __shfl_xor(v0[e], 16); p1[e] = __shfl_xor(v1[e], 16); }
                        v0 = v0 * c0 + p0 * s0; v1 = v1 * c1 + p1 * s1; }
                    *(u32x4*)(base + (size_t)row * 1024 + col0 + bj * HALF) = pk8(v0, v1); } }
    }
};
struct EpiP3a {
    static constexpr bool PERM = true, AFTER_DRAIN = false;
    bf16_t* gates; bf16_t* oa; const float* rstd;
    __device__ __forceinline__ void operator()(const f32x4 (&acc)[2][2][4][2], const Unit& u, int wr, int wc, int fr, int fq) const {
        const bool isg = u.pn < 8; const int col0 = (isg ? u.pn * BM : (u.pn - 8) * BM) + wc * 32 + 8 * fq;
#pragma unroll
        for (int ai = 0; ai < 2; ++ai)
#pragma unroll
            for (int m = 0; m < 4; ++m) { const int row = u.pm * BM + ai * HALF + wr * 64 + m * 16 + fr; const float rs = rstd[row];
#pragma unroll
                for (int bj = 0; bj < 2; ++bj) { f32x4 v0 = acc[ai][bj][m][0] * rs, v1 = acc[ai][bj][m][1] * rs;
#pragma unroll
                    for (int e = 0; e < 4; ++e) { v0[e] = sigmoidf_(v0[e]); v1[e] = sigmoidf_(v1[e]); }
                    if (isg) { *(u32x4*)(gates + (size_t)row * 2048 + col0 + bj * HALF) = pk8(v0, v1); }
                    else { u32x4* p = (u32x4*)(oa + (size_t)row * 1024 + col0 + bj * HALF); const u32x4 o = *p; const f32x4 z0 = acc[ai][bj][m][0] * rs, z1 = acc[ai][bj][m][1] * rs;
                        f32x4 a0 = {bflo(o.x), bfhi(o.x), bflo(o.y), bfhi(o.y)}, a1 = {bflo(o.z), bfhi(o.z), bflo(o.w), bfhi(o.w)};
                        a0 = a0 * (z0 * v0); a1 = a1 * (z1 * v1); *p = pk8(a0, a1); } } }
    }
};
struct EpiP3b {
    static constexpr bool PERM = true, AFTER_DRAIN = false;
    const bf16_t* gates; bf16_t* merged;
    __device__ __forceinline__ void operator()(const f32x4 (&acc)[2][2][4][2], const Unit& u, int wr, int wc, int fr, int fq) const {
        const bool second = u.pn >= 4; const int col0 = (u.pn & 3) * BM + wc * 32 + 8 * fq;
#pragma unroll
        for (int ai = 0; ai < 2; ++ai)
#pragma unroll
            for (int m = 0; m < 4; ++m) { const int row = u.pm * BM + ai * HALF + wr * 64 + m * 16 + fr;
#pragma unroll
                for (int bj = 0; bj < 2; ++bj) { const u32x4 g = *(const u32x4*)(gates + (size_t)row * 2048 + (second ? 1024 : 0) + col0 + bj * HALF);
                    const f32x4 g0 = {bflo(g.x), bfhi(g.x), bflo(g.y), bfhi(g.y)}, g1 = {bflo(g.z), bfhi(g.z), bflo(g.w), bfhi(g.w)};
                    f32x4 v0 = acc[ai][bj][m][0] * g0, v1 = acc[ai][bj][m][1] * g1; u32x4* p = (u32x4*)(merged + (size_t)row * 1024 + col0 + bj * HALF);
                    if (second) { const u32x4 t = *p; v0 = v0 + (f32x4){bflo(t.x), bfhi(t.x), bflo(t.y), bfhi(t.y)}; v1 = v1 + (f32x4){bflo(t.z), bfhi(t.z), bflo(t.w), bfhi(t.w)}; }
                    *p = pk8(v0, v1); } }
    }
};
struct EpiRes {
    static constexpr bool PERM = false, AFTER_DRAIN = false;
    const float* res; float* xo; bf16_t* xb; float* ss;
    __device__ __forceinline__ void operator()(const f32x4 (&acc)[2][2][4][2], const Unit& u, int wr, int wc, int fr, int fq) const {
        const int col0 = u.pn * BM + wc * 32 + 4 * fq;
#pragma unroll
        for (int ai = 0; ai < 2; ++ai)
#pragma unroll
            for (int m = 0; m < 4; ++m) { const int row = u.pm * BM + ai * HALF + wr * 64 + m * 16 + fr; const size_t off = (size_t)row * 1024 + col0; float s = 0.f;
#pragma unroll
                for (int bj = 0; bj < 2; ++bj)
#pragma unroll
                    for (int n = 0; n < 2; ++n) { const size_t o = off + bj * HALF + n * 16; const f32x4 v = *(const f32x4*)(res + o) + acc[ai][bj][m][n]; *(f32x4*)(xo + o) = v;
                        s += (v[0] * v[0] + v[1] * v[1]) + (v[2] * v[2] + v[3] * v[3]);
                        if (xb) { u32x2 w; w.x = cvt_pk_bf16(v[0], v[1]); w.y = cvt_pk_bf16(v[2], v[3]); *(u32x2*)(xb + o) = w; } }
                s += __shfl_xor(s, 16); s += __shfl_xor(s, 32);
                if (fq == 0) ss[(size_t)row * 16 + u.pn * 4 + wc] = s;
                if (m & 1) asm volatile("" ::: "memory"); }
    }
};
struct EpiRowBf16 {
    static constexpr bool PERM = true, AFTER_DRAIN = false;
    bf16_t* out; int ldc; const float* rs1; const float* ss16;
    __device__ __forceinline__ void operator()(const f32x4 (&acc)[2][2][4][2], const Unit& u, int wr, int wc, int fr, int fq) const {
        const int col0 = u.pn * BM + wc * 32 + 8 * fq;
#pragma unroll
        for (int ai = 0; ai < 2; ++ai)
#pragma unroll
            for (int m = 0; m < 4; ++m) { const int row = u.pm * BM + ai * HALF + wr * 64 + m * 16 + fr; const float rs = ss16 ? rstd16(ss16 + (size_t)row * 16) : rs1[row];
#pragma unroll
                for (int bj = 0; bj < 2; ++bj) *(u32x4*)(out + (size_t)row * ldc + col0 + bj * HALF) = pk8(acc[ai][bj][m][0] * rs, acc[ai][bj][m][1] * rs); }
    }
};
struct EpiAct {
    static constexpr bool PERM = true, AFTER_DRAIN = false;
    bf16_t* act; const float* ss16;
    __device__ __forceinline__ void operator()(const f32x4 (&acc)[2][2][4][2], const Unit& u, int wr, int wc, int fr, int fq) const {
        const int col0 = u.pn * HALF + wc * 32 + 8 * fq;
#pragma unroll
        for (int ai = 0; ai < 2; ++ai)
#pragma unroll
            for (int m = 0; m < 4; ++m) { const int row = u.pm * BM + ai * HALF + wr * 64 + m * 16 + fr; const float rs = rstd16(ss16 + (size_t)row * 16);
                f32x4 a[2];
#pragma unroll
                for (int n = 0; n < 2; ++n) { const f32x4 g = acc[ai][0][m][n] * rs, up = acc[ai][1][m][n] * rs;
#pragma unroll
                    for (int e = 0; e < 4; ++e) a[n][e] = g[e] * sigmoidf_(g[e]) * up[e]; }
                *(u32x4*)(act + (size_t)row * 2816 + col0) = pk8(a[0], a[1]); }
    }
};
struct PairOrder {
    StaticOrder so;
    __device__ void init(int M, int G_, int c_) { so.init(M, 1024, G_, c_); }
    __device__ bool next(int i, Unit& u) const { if (!so.next(i >> 1, u)) return false; u.pn += 4 * (i & 1); return true; }
    __device__ __forceinline__ void a_ready(const Unit&) const {}
    __device__ __forceinline__ void done(const Unit&) const {}
};
template <class Epi, class Sched, bool ALIGN_EPI = false, bool SP2 = false>
__device__ __forceinline__ void gemm_phase(PG8_LAS unsigned char* lds, const Gemm g, const Sched& S, const Epi& E, const int wid) {
    const int lane = lane_id(), tid = wid * 64 + lane, wr = wid >> 2, wc = wid & 3, fr = lane & 15, fq = lane >> 4;
    const int K = g.K, nt = K / BK;
    unsigned voffA[2], voffB[2];
#pragma unroll
    for (int i = 0; i < 2; ++i) { int R, C; stage_rc(tid * 16 + i * 8192, R, C); const int Rb = Epi::PERM ? ((R & ~31) + perm32(R & 31)) : R;
        voffA[i] = (unsigned)(R * K + C) * 2u; voffB[i] = (unsigned)(Rb * K + C) * 2u; }
    const size_t kstep = (size_t)(BK * 2);
    const size_t hstep = (size_t)HALF * K * 2;
    const size_t tstep = 2 * hstep;
    const unsigned ldsw = (unsigned)wid * 1024u;
    const int aoff = lds_byte(wr * 64 + fr, fq * 8), boff = lds_byte(wc * 32 + fr, fq * 8);
#define PG8_SA(b, h) (((b) * 2 + (h)) * HTB)
#define PG8_SB(b, h) ((4 + (b) * 2 + (h)) * HTB)
#define PG8_STAGE(bufoff, gbase, voff) do { _Pragma("unroll") for (int _i = 0; _i < 2; ++_i) \
        __builtin_amdgcn_global_load_lds((const unsigned*)((const char*)(gbase) + (voff)[_i]), (PG8_LAS unsigned*)(lds + (bufoff) + ldsw + _i * 8192), 16, 0, 0); } while (0)
#define PG8_LDA(dst, b, h) do { _Pragma("unroll") for (int m = 0; m < 4; ++m) _Pragma("unroll") for (int k = 0; k < 2; ++k) dst[m][k] = *(const PG8_LAS bf16x8*)(lds + PG8_SA(b, h) + aoff + m * 2048 + k * 1024); } while (0)
#define PG8_LDB(dst, b, h) do { _Pragma("unroll") for (int n = 0; n < 2; ++n) _Pragma("unroll") for (int k = 0; k < 2; ++k) dst[n][k] = *(const PG8_LAS bf16x8*)(lds + PG8_SB(b, h) + boff + n * 2048 + k * 1024); } while (0)
#define PG8_MMA(ai, bj, At, Bt) do { __builtin_amdgcn_s_setprio(1); _Pragma("unroll") for (int m = 0; m < 4; ++m) _Pragma("unroll") for (int n = 0; n < 2; ++n) _Pragma("unroll") for (int k = 0; k < 2; ++k) \
        acc[ai][bj][m][n] = __builtin_amdgcn_mfma_f32_16x16x32_bf16(Bt[n][k], At[m][k], acc[ai][bj][m][n], 0, 0, 0); __builtin_amdgcn_s_setprio(0); } while (0)
#define PG8_WAIT_V(n) asm volatile("s_waitcnt vmcnt(" #n ")" ::: "memory")
#define PG8_WAIT_L(n) asm volatile("s_waitcnt lgkmcnt(" #n ")" ::: "memory")
#define PG8_BAR __builtin_amdgcn_s_barrier()
#define PG8_SCHED __builtin_amdgcn_sched_barrier(0)
    Unit cur, nxt; int ui = 0;
    if (!S.next(0, cur)) return;
    f32x4 acc[2][2][4][2];
#pragma unroll
    for (int a = 0; a < 2; ++a)
#pragma unroll
        for (int b = 0; b < 2; ++b)
#pragma unroll
            for (int m = 0; m < 4; ++m)
#pragma unroll
                for (int n = 0; n < 2; ++n) acc[a][b][m][n] = (f32x4){0.f, 0.f, 0.f, 0.f};
    bf16x8 At[4][2], B0[2][2], B1[2][2];
    const char* cA = (const char*)g.A + (size_t)cur.pm * tstep + (cur.pn >= g.a_split ? g.a_delta : 0L); const char* cB = (const char*)g.Bt + (size_t)cur.pn * tstep;
    S.a_ready(cur);
    if constexpr (SP2) {
        PG8_STAGE(PG8_SB(0, 0), cB, voffB); PG8_STAGE(PG8_SB(0, 1), cB + hstep, voffB); PG8_STAGE(PG8_SA(0, 0), cA, voffA); PG8_STAGE(PG8_SA(0, 1), cA + hstep, voffA);
        if (wr == 1) PG8_BAR;
        PG8_WAIT_V(2); PG8_BAR;
        PG8_STAGE(PG8_SB(1, 0), cB + kstep, voffB); PG8_STAGE(PG8_SA(1, 0), cA + kstep, voffA); PG8_STAGE(PG8_SB(1, 1), cB + hstep + kstep, voffB);
        PG8_WAIT_V(6); PG8_BAR;
    } else {
        PG8_STAGE(PG8_SB(0, 0), cB, voffB); PG8_STAGE(PG8_SA(0, 0), cA, voffA); PG8_STAGE(PG8_SB(0, 1), cB + hstep, voffB); PG8_STAGE(PG8_SA(0, 1), cA + hstep, voffA);
        if (wr == 1) PG8_BAR;
        PG8_WAIT_V(4); PG8_BAR;
        PG8_STAGE(PG8_SB(1, 0), cB + kstep, voffB); PG8_STAGE(PG8_SA(1, 0), cA + kstep, voffA); PG8_STAGE(PG8_SB(1, 1), cB + hstep + kstep, voffB);
        PG8_WAIT_V(6); PG8_BAR;
    }
    for (;;) {
        const bool has_next = S.next(ui + 1, nxt);
        const char* nA = has_next ? (const char*)g.A + (size_t)nxt.pm * tstep + (nxt.pn >= g.a_split ? g.a_delta : 0L) : cA; const char* nB = has_next ? (const char*)g.Bt + (size_t)nxt.pn * tstep : cB;
        for (int t = 0; t < nt; t += 2) {
            const bool last = (t == nt - 2);
            const char* a1 = cA + (size_t)(t + 1) * kstep;
            const char* a2 = last ? nA : cA + (size_t)(t + 2) * kstep; const char* b2 = last ? nB : cB + (size_t)(t + 2) * kstep;
            const char* a3 = a2 + kstep; const char* b3 = b2 + kstep;
            if (last && has_next) S.a_ready(nxt);
            if constexpr (SP2) {
            PG8_LDB(B0, 0, 0); PG8_LDB(B1, 0, 1); PG8_SCHED; PG8_LDA(At, 0, 0); PG8_STAGE(PG8_SA(1, 1), a1 + hstep, voffA);
            PG8_WAIT_V(8); PG8_WAIT_L(0); PG8_BAR; PG8_MMA(0, 0, At, B0); PG8_MMA(0, 1, At, B1); PG8_BAR; PG8_SCHED;
            PG8_LDA(At, 0, 1); PG8_STAGE(PG8_SB(0, 0), b2, voffB); PG8_STAGE(PG8_SB(0, 1), b2 + hstep, voffB); PG8_STAGE(PG8_SA(0, 0), a2, voffA);
            PG8_WAIT_V(8); PG8_WAIT_L(0); PG8_BAR; PG8_MMA(1, 0, At, B0); PG8_MMA(1, 1, At, B1); PG8_BAR; PG8_SCHED;
            PG8_LDB(B0, 1, 0); PG8_LDB(B1, 1, 1); PG8_SCHED; PG8_LDA(At, 1, 0); PG8_STAGE(PG8_SA(0, 1), a2 + hstep, voffA);
            PG8_WAIT_V(8); PG8_WAIT_L(0); PG8_BAR; PG8_MMA(0, 0, At, B0); PG8_MMA(0, 1, At, B1); PG8_BAR; PG8_SCHED;
            PG8_LDA(At, 1, 1); PG8_STAGE(PG8_SB(1, 0), b3, voffB); PG8_STAGE(PG8_SB(1, 1), b3 + hstep, voffB); PG8_STAGE(PG8_SA(1, 0), a3, voffA);
            PG8_WAIT_V(8); PG8_WAIT_L(0); PG8_BAR; PG8_MMA(1, 0, At, B0); PG8_MMA(1, 1, At, B1); PG8_BAR; PG8_SCHED;
            } else {
            PG8_LDB(B0, 0, 0); PG8_SCHED; PG8_LDA(At, 0, 0); PG8_STAGE(PG8_SA(1, 1), a1 + hstep, voffA);
            PG8_WAIT_L(8); PG8_BAR; PG8_WAIT_L(0); PG8_MMA(0, 0, At, B0); PG8_BAR; PG8_SCHED;
            PG8_LDB(B1, 0, 1); PG8_STAGE(PG8_SB(0, 0), b2, voffB);
            PG8_BAR; PG8_WAIT_L(0); PG8_MMA(0, 1, At, B1); PG8_BAR;
            PG8_LDA(At, 0, 1); PG8_STAGE(PG8_SA(0, 0), a2, voffA);
            PG8_BAR; PG8_WAIT_L(0); PG8_MMA(1, 0, At, B0); PG8_BAR; PG8_SCHED;
            PG8_STAGE(PG8_SB(0, 1), b2 + hstep, voffB);
            PG8_WAIT_V(6); PG8_BAR; PG8_MMA(1, 1, At, B1); PG8_BAR;
            PG8_LDB(B0, 1, 0); PG8_SCHED; PG8_LDA(At, 1, 0); PG8_STAGE(PG8_SA(0, 1), a2 + hstep, voffA);
            PG8_WAIT_L(8); PG8_BAR; PG8_WAIT_L(0); PG8_MMA(0, 0, At, B0); PG8_BAR; PG8_SCHED;
            PG8_LDB(B1, 1, 1); PG8_STAGE(PG8_SB(1, 0), b3, voffB);
            PG8_BAR; PG8_WAIT_L(0); PG8_MMA(0, 1, At, B1); PG8_BAR;
            PG8_LDA(At, 1, 1); PG8_STAGE(PG8_SA(1, 0), a3, voffA);
            PG8_BAR; PG8_WAIT_L(0); PG8_MMA(1, 0, At, B0); PG8_BAR; PG8_SCHED;
            PG8_STAGE(PG8_SB(1, 1), b3 + hstep, voffB);
            PG8_WAIT_V(6); PG8_BAR; PG8_MMA(1, 1, At, B1); PG8_BAR;
            }
        }
        if constexpr (ALIGN_EPI) { if (wr == 0) PG8_BAR; }
        if constexpr (!Epi::AFTER_DRAIN) { E(acc, cur, wr, wc, fr, fq); S.done(cur); }
        if (!has_next) break;
#pragma unroll
        for (int a = 0; a < 2; ++a)
#pragma unroll
            for (int b = 0; b < 2; ++b)
#pragma unroll
                for (int m = 0; m < 4; ++m)
#pragma unroll
                    for (int n = 0; n < 2; ++n) acc[a][b][m][n] = (f32x4){0.f, 0.f, 0.f, 0.f};
        cur = nxt; cA = nA; cB = nB; ++ui;
        if constexpr (ALIGN_EPI) { if (wr == 1) PG8_BAR; }
    }
    PG8_WAIT_V(0);
    if constexpr (!ALIGN_EPI) { if (wr == 0) PG8_BAR; }
    PG8_BAR;
    if constexpr (Epi::AFTER_DRAIN) { E.fused(acc, cur, wr, wc, fr, fq, lds, wid, lane); S.done(cur); }
#undef PG8_SA
#undef PG8_SB
#undef PG8_STAGE
#undef PG8_LDA
#undef PG8_LDB
#undef PG8_MMA
#undef PG8_WAIT_V
#undef PG8_WAIT_L
#undef PG8_BAR
#undef PG8_SCHED
}
}
#include <hip/hip_bf16.h>
#include <cmath>
namespace attn_body {
using bf16=__hip_bfloat16;
using bf16x8=__attribute__((ext_vector_type(8)))short;
using s16x4=__attribute__((ext_vector_type(4)))short;
using f32x16=__attribute__((ext_vector_type(16)))float;
using u32x4=__attribute__((ext_vector_type(4)))unsigned;
constexpr int BATCH=4,NHEAD=16,SEQ=4096,D=64,DM=1024;
constexpr int NW=8,QBLK=32,QB=QBLK*NW,KVBLK=64,NQB=SEQ/QB;
constexpr int ATTN_PITCH=DM, ATTN_UNIT_ROWS=QB;
__device__ __forceinline__ int crow(int r,int hi){return (r&3)+8*(r>>2)+4*hi;}
#define SBAR() __builtin_amdgcn_sched_barrier(0)
__device__ __forceinline__ void cmask(f32x16&p0,f32x16&p1,int jb,int qrel,int hi){
  const float NEG=-INFINITY; int kb=64*jb+4*hi;
  #pragma unroll
  for(int r=0;r<16;++r){int kv=kb+(r&3)+8*(r>>2); if(kv>qrel)p0[r]=NEG; if(kv+32>qrel)p1[r]=NEG;}
}

constexpr int NSLOT=3, SLOTB=8192;
constexpr int LDS_K=0, LDS_V=NSLOT*SLOTB, LDS_WS=2*NSLOT*SLOTB, LDS_OST=LDS_WS+NW*64*4, LDS_STA=LDS_OST+NW*4096, LDS_STC=LDS_STA+NW*4096, LDS_BYTES=LDS_STC+NW*4096;
constexpr float C2=0.125f*1.4426950408889634f;
__device__ __forceinline__ void glds16(const void*gsrc,unsigned lds_dst){unsigned keep;
  asm volatile("s_mov_b32 %0, m0\n\ts_mov_b32 m0, %2\n\ts_nop 0\n\tglobal_load_lds_dwordx4 %1, off\n\ts_mov_b32 m0, %0":"=&s"(keep):"v"(gsrc),"s"(lds_dst):"memory");}
__device__ __forceinline__ float max3f(float a,float b,float c){float r;asm("v_max3_f32 %0, %1, %2, %3":"=v"(r):"v"(a),"v"(b),"v"(c));return r;}
__device__ __forceinline__ float max2f(float a,float b){float r;asm("v_max_f32_e32 %0, %1, %2":"=v"(r):"v"(a),"v"(b));return r;}
__device__ __forceinline__ float fadd_s(float a,float b){float r;asm("v_add_f32_e32 %0, %1, %2":"=v"(r):"v"(a),"v"(b));return r;}
__device__ __forceinline__ float fsub_s(float a,float b){float r;asm("v_sub_f32_e32 %0, %1, %2":"=v"(r):"v"(a),"v"(b));return r;}
typedef float f32x2_t __attribute__((ext_vector_type(2))); typedef __bf16 bf16x2_t __attribute__((ext_vector_type(2)));
__device__ __forceinline__ unsigned cvtpk_s(float lo,float hi){f32x2_t v={lo,hi};bf16x2_t b=__builtin_convertvector(v,bf16x2_t);return __builtin_bit_cast(unsigned,b);}
#define WAIT_BAR(N) asm volatile("s_waitcnt vmcnt(" #N ") lgkmcnt(0)\n\ts_barrier":::"memory")

__device__ __forceinline__ void qkt(f32x16&p0,f32x16&p1,const char*Kslot,const bf16x8*qr,const f32x16&negm,int r32,int hi){
  const char*kb=Kslot+hi*1024+r32*16;
  #pragma unroll
  for(int d0=0;d0<4;++d0){
    const bf16x8 b0=*reinterpret_cast<const bf16x8*>(kb+d0*2048);
    const bf16x8 b1=*reinterpret_cast<const bf16x8*>(kb+d0*2048+512);
    if(d0==0){p0=__builtin_amdgcn_mfma_f32_32x32x16_bf16(b0,qr[0],negm,0,0,0);p1=__builtin_amdgcn_mfma_f32_32x32x16_bf16(b1,qr[0],negm,0,0,0);}
    else{p0=__builtin_amdgcn_mfma_f32_32x32x16_bf16(b0,qr[d0],p0,0,0,0);p1=__builtin_amdgcn_mfma_f32_32x32x16_bf16(b1,qr[d0],p1,0,0,0);}}
}
typedef __attribute__((address_space(3))) const char* lds_cptr;
typedef short v4i16_t __attribute__((ext_vector_type(4)));
__device__ __forceinline__ void kload8(bf16x8*kf,lds_cptr kp){
  kf[0]=*(const __attribute__((address_space(3))) bf16x8*)(kp);      kf[1]=*(const __attribute__((address_space(3))) bf16x8*)(kp+512);
  kf[2]=*(const __attribute__((address_space(3))) bf16x8*)(kp+2048); kf[3]=*(const __attribute__((address_space(3))) bf16x8*)(kp+2560);
  kf[4]=*(const __attribute__((address_space(3))) bf16x8*)(kp+4096); kf[5]=*(const __attribute__((address_space(3))) bf16x8*)(kp+4608);
  kf[6]=*(const __attribute__((address_space(3))) bf16x8*)(kp+6144); kf[7]=*(const __attribute__((address_space(3))) bf16x8*)(kp+6656);
}
__device__ __forceinline__ void kload2(bf16x8*kf,lds_cptr kp,int j){ kf[2*j]=*(const __attribute__((address_space(3))) bf16x8*)(kp+j*2048); kf[2*j+1]=*(const __attribute__((address_space(3))) bf16x8*)(kp+j*2048+512); }
__device__ __forceinline__ s16x4 vtr(lds_cptr p){ return __builtin_bit_cast(s16x4,__builtin_amdgcn_ds_read_tr16_b64_v4i16((__attribute__((address_space(3))) v4i16_t*)p)); }
__device__ __forceinline__ float rowmax(const f32x16&p0,const f32x16&p1){
  float a=max3f(p0[0],p0[1],p1[0]),b=max3f(p0[2],p0[3],p1[1]);a=max3f(a,p1[2],p1[3]);
  #pragma unroll
  for(int r=4;r<16;r+=4){a=max3f(a,p0[r],p0[r+1]);b=max3f(b,p0[r+2],p0[r+3]);a=max3f(a,p1[r],p1[r+1]);b=max3f(b,p1[r+2],p1[r+3]);}
  const float m=max2f(a,b);
  auto rr=__builtin_amdgcn_permlane32_swap(__float_as_uint(m),__float_as_uint(m),false,false);
  return max2f(__uint_as_float(rr[0]),__uint_as_float(rr[1]));
}
__device__ __forceinline__ void pv(f32x16*o,int vb,bf16x8 pa0,bf16x8 pa1,bf16x8 pa2,bf16x8 pa3){
  #pragma unroll
  for(int d0=0;d0<2;++d0){s16x4 lo[4],hi[4];
    #pragma unroll
    for(int ks=0;ks<4;++ks){
      asm volatile("ds_read_b64_tr_b16 %0,%1 offset:%c2":"=&v"(lo[ks]):"v"(vb),"i"(d0*4096+ks*1024):"memory");
      asm volatile("ds_read_b64_tr_b16 %0,%1 offset:%c2":"=&v"(hi[ks]):"v"(vb),"i"(d0*4096+ks*1024+512):"memory");}
    asm volatile("s_waitcnt lgkmcnt(0)":::"memory");SBAR();
    #define PK(k) (bf16x8){lo[k][0],lo[k][1],lo[k][2],lo[k][3],hi[k][0],hi[k][1],hi[k][2],hi[k][3]}
    o[d0]=__builtin_amdgcn_mfma_f32_32x32x16_bf16(pa0,PK(0),o[d0],0,0,0);
    o[d0]=__builtin_amdgcn_mfma_f32_32x32x16_bf16(pa1,PK(1),o[d0],0,0,0);
    o[d0]=__builtin_amdgcn_mfma_f32_32x32x16_bf16(pa2,PK(2),o[d0],0,0,0);
    o[d0]=__builtin_amdgcn_mfma_f32_32x32x16_bf16(pa3,PK(3),o[d0],0,0,0);
    #undef PK
  }
}

#ifndef ATTN_STORE16
#define ATTN_STORE16(p,v) (*(u32x4*)(p)=(v))
#endif
template<int THRL> __device__ __forceinline__ void attn_unit(int b,int qcol,int vcol,int ocol,int qb,int mode,float lam,const bf16*Q,const bf16*K,const bf16*V,bf16*O,char*shm,const int wid){
  const int lane=lane_id(),r32=lane&31,hi=lane>>5;
  const long rowbase=(long)b*SEQ; const int q0=qb*QB;
  const bf16*Qw=Q+(rowbase+q0+wid*QBLK)*DM+qcol;
  const bf16*Kh=K+rowbase*DM+qcol,*Vh=V+rowbase*DM+vcol;
  const unsigned lds0=(unsigned)(uintptr_t)shm;
  float*wsf=(float*)(shm+LDS_WS)+wid*64;
  const bf16*ksrc=Kh+(long)lane*DM+wid*8;
  const bf16*vsrc=Vh+(long)(16*(wid&3)+(lane>>2))*DM+(wid>>2)*32+(lane&3)*8;
  const unsigned kdst=lds0+LDS_K+wid*1024, vdst=lds0+LDS_V+wid*1024;
  #define DMA_K(t,slot) glds16(ksrc+(long)(t)*KVBLK*DM,(unsigned)__builtin_amdgcn_readfirstlane(kdst+(slot)))
  #define DMA_V(t,slot) glds16(vsrc+(long)(t)*KVBLK*DM,(unsigned)__builtin_amdgcn_readfirstlane(vdst+(slot)))
  const int vb0=(int)(lds0+LDS_V)+((lane>>4)&1)*32+(lane&3)*8+(4*hi+((lane&15)>>2))*64;
  const char*Kbase=shm+LDS_K; bf16x8 kf[8];
  const lds_cptr shm3=(lds_cptr)shm; const lds_cptr kp0=shm3+LDS_K+hi*1024+r32*16; const lds_cptr vp0=shm3+LDS_V+((lane>>4)&1)*32+(lane&3)*8+(4*hi+((lane&15)>>2))*64;
  const int NT=(q0+QB)/KVBLK;
  DMA_K(0,0);DMA_V(0,0);DMA_K(1,SLOTB);
  bf16x8 qr[4];
  #pragma unroll
  for(int d0=0;d0<4;++d0)qr[d0]=*reinterpret_cast<const bf16x8*>(&Qw[(long)r32*DM+d0*16+hi*8]);
  float mhat=0.f,l_reg=0.f;f32x16 o[2];o[0]=f32x16{};o[1]=f32x16{};f32x16 negm=f32x16{};asm volatile("":"+v"(negm));
  const int qrel=wid*QBLK+r32;
  #define CMASK(P0,P1,t) do{int jb_=(t)-(NT-4); if(jb_>=0)cmask(P0,P1,jb_,qrel,hi);}while(0)
  bool resc=false;
  #define START(P0,P1) do{ const float rm=rowmax(P0,P1); resc=false; \
    { const float dl=rm; mhat=fadd_s(mhat,dl); \
      _Pragma("unroll") for(int r=0;r<16;++r){P0[r]=fsub_s(P0[r],dl);P1[r]=fsub_s(P1[r],dl);} \
      _Pragma("unroll") for(int r=0;r<16;++r)negm[r]=-mhat; asm volatile("":"+v"(negm)); } \
    _Pragma("unroll") for(int r=0;r<16;++r)P0[r]=__builtin_amdgcn_exp2f(P0[r]); }while(0)
  #define RESC() do{ if(resc){ asm volatile("s_waitcnt lgkmcnt(0)":::"memory"); \
      _Pragma("unroll") for(int d_=0;d_<2;++d_) _Pragma("unroll") for(int r=0;r<16;++r)o[d_][r]*=wsf[crow(r,hi)]; } }while(0)
  f32x16 pA0,pA1,pB0,pB1;
  int sl_prev=0,sl_cur=0,sl_next=SLOTB;
  #define ROT() do{sl_prev=sl_cur;sl_cur=sl_next;sl_next=(sl_next==(NSLOT-1)*SLOTB)?0:sl_next+SLOTB;}while(0)
  DMA_K(2,2*SLOTB);
  WAIT_BAR(3);
  qkt(pA0,pA1,Kbase,qr,negm,r32,hi);asm volatile("s_nop 15\n\ts_nop 7":"+v"(pA0),"+v"(pA1));CMASK(pA0,pA1,0);
  START(pA0,pA1);
  _Pragma("unroll") for(int r=0;r<16;++r)pA1[r]=__builtin_amdgcn_exp2f(pA1[r]);
  WAIT_BAR(0);
  DMA_K(3,0);DMA_V(1,SLOTB);
  ROT();
  kload8(kf,kp0+sl_cur);
  WAIT_BAR(2);
  s16x4 vlo[8],vhi[8]; u32x4 pw0,pw1,pw2,pw3;
  #define PKW(P,B) cvtpk_s(P[B],P[B+1])
  #define PAF(k) __builtin_bit_cast(bf16x8,pw##k)
  #define VFR(i) (bf16x8){vlo[i][0],vlo[i][1],vlo[i][2],vlo[i][3],vhi[i][0],vhi[i][1],vhi[i][2],vhi[i][3]}
  #define PIN(x) asm volatile("":"+v"(x))
  #define MX3(a,b,c) __builtin_fmaxf(__builtin_fmaxf((a),(b)),(c))
  #define GAPA(MF,A0,A1,A2,A3,W0,W1,PW) do{ MF; sacc+=A0; sacc+=A1; sacc+=A2; sacc+=A3; PIN(sacc); W0; W1; PIN(PW); SBAR(); }while(0)
  #define EX(v) __builtin_amdgcn_exp2f(v)
  #define GAPB(MF,X,B) do{ MF; X[B]=EX(X[B]); X[B+1]=EX(X[B+1]); X[B+2]=EX(X[B+2]); X[B+3]=EX(X[B+3]); PIN(X); SBAR(); }while(0)
  #define VRD(i) do{ vlo[i]=vtr(vp_+(((i)>>2)*4096+((i)&3)*1024)); vhi[i]=vtr(vp_+(((i)>>2)*4096+((i)&3)*1024+512)); }while(0)
  #define KRD(G,j) do{ if(G){ kload2(kf,kp0+sl_next,j); SBAR(); } }while(0)
  #define STEP(C0,C1,P0,P1,t,GK,GV,GL) do{ SBAR(); \
    const lds_cptr vp_=vp0+sl_prev; \
    VRD(0); SBAR(); float sacc=(P0[0]+P0[1]); \
    GAPA(C0=__builtin_amdgcn_mfma_f32_32x32x16_bf16(kf[0],qr[0],negm,0,0,0), P0[2],P0[3],P0[4],P0[5],     pw0[0]=PKW(P0,0), pw0[1]=PKW(P0,2), pw0); \
    VRD(4); SBAR(); GAPA(C1=__builtin_amdgcn_mfma_f32_32x32x16_bf16(kf[1],qr[0],negm,0,0,0), P0[6],P0[7],P0[8],P0[9],     pw0[2]=PKW(P0,4), pw0[3]=PKW(P0,6), pw0); \
    VRD(1); SBAR(); GAPA(C0=__builtin_amdgcn_mfma_f32_32x32x16_bf16(kf[2],qr[1],C0,0,0,0),   P0[10],P0[11],P0[12],P0[13], pw1[0]=PKW(P0,8), pw1[1]=PKW(P0,10), pw1); \
    VRD(5); SBAR(); GAPA(C1=__builtin_amdgcn_mfma_f32_32x32x16_bf16(kf[3],qr[1],C1,0,0,0),   P0[14],P0[15],P1[0],P1[1],   pw1[2]=PKW(P0,12),pw1[3]=PKW(P0,14), pw1); \
    VRD(2); SBAR(); GAPA(C0=__builtin_amdgcn_mfma_f32_32x32x16_bf16(kf[4],qr[2],C0,0,0,0),   P1[2],P1[3],P1[4],P1[5],     pw2[0]=PKW(P1,0), pw2[1]=PKW(P1,2), pw2); \
    VRD(6); SBAR(); GAPA(C1=__builtin_amdgcn_mfma_f32_32x32x16_bf16(kf[5],qr[2],C1,0,0,0),   P1[6],P1[7],P1[8],P1[9],     pw2[2]=PKW(P1,4), pw2[3]=PKW(P1,6), pw2); \
    VRD(3); SBAR(); GAPA(C0=__builtin_amdgcn_mfma_f32_32x32x16_bf16(kf[6],qr[3],C0,0,0,0),   P1[10],P1[11],P1[12],P1[13], pw3[0]=PKW(P1,8), pw3[1]=PKW(P1,10), pw3); \
    VRD(7); SBAR(); GAPA(C1=__builtin_amdgcn_mfma_f32_32x32x16_bf16(kf[7],qr[3],C1,0,0,0),   P1[14],P1[15],0.f,0.f,       pw3[2]=PKW(P1,12),pw3[3]=PKW(P1,14), pw3); \
    l_reg+=sacc; \
    if(GK){DMA_K((t)+3,sl_cur);} if(GV){DMA_V((t)+1,sl_next);} \
    CMASK(C0,C1,t); \
    { float a=MX3(C0[0],C0[1],C1[0]),b=MX3(C0[2],C0[3],C1[1]); a=MX3(a,C1[2],C1[3]); \
      _Pragma("unroll") for(int r=4;r<16;r+=4){a=MX3(a,C0[r],C0[r+1]);b=MX3(b,C0[r+2],C0[r+3]);a=MX3(a,C1[r],C1[r+1]);b=MX3(b,C1[r+2],C1[r+3]);} \
      float rm=__builtin_fmaxf(a,b); { auto rr=__builtin_amdgcn_permlane32_swap(__float_as_uint(rm),__float_as_uint(rm),false,false); rm=__builtin_fmaxf(__uint_as_float(rr[0]),__uint_as_float(rr[1])); } \
      resc=false; \
      if(__builtin_expect(__any(rm>(float)THRL),0)){ const float dl=__builtin_fmaxf(rm,0.f); mhat+=dl; \
        _Pragma("unroll") for(int r=0;r<16;++r){C0[r]-=dl;C1[r]-=dl;} \
        _Pragma("unroll") for(int r=0;r<16;++r)negm[r]=-mhat; asm volatile("":"+v"(negm)); \
        const float f=__builtin_amdgcn_exp2f(-dl); l_reg*=f; if(hi==0)wsf[r32]=f; resc=true; } } \
    SBAR(); \
    GAPB(o[0]=__builtin_amdgcn_mfma_f32_32x32x16_bf16(PAF(0),VFR(0),o[0],0,0,0), C0,0); \
    GAPB(o[1]=__builtin_amdgcn_mfma_f32_32x32x16_bf16(PAF(0),VFR(4),o[1],0,0,0), C0,4); \
    KRD(GL,0); GAPB(o[0]=__builtin_amdgcn_mfma_f32_32x32x16_bf16(PAF(1),VFR(1),o[0],0,0,0), C0,8); \
    KRD(GL,1); GAPB(o[1]=__builtin_amdgcn_mfma_f32_32x32x16_bf16(PAF(1),VFR(5),o[1],0,0,0), C0,12); \
    KRD(GL,2); GAPB(o[0]=__builtin_amdgcn_mfma_f32_32x32x16_bf16(PAF(2),VFR(2),o[0],0,0,0), C1,0); \
    KRD(GL,3); GAPB(o[1]=__builtin_amdgcn_mfma_f32_32x32x16_bf16(PAF(2),VFR(6),o[1],0,0,0), C1,4); \
    GAPB(o[0]=__builtin_amdgcn_mfma_f32_32x32x16_bf16(PAF(3),VFR(3),o[0],0,0,0), C1,8); \
    GAPB(o[1]=__builtin_amdgcn_mfma_f32_32x32x16_bf16(PAF(3),VFR(7),o[1],0,0,0), C1,12); \
    }while(0)
  int t=1;
  #undef CMASK
  #define CMASK(P0,P1,t) do{}while(0)
  for(;t+5<NT;t+=2){
    STEP(pB0,pB1,pA0,pA1,t,true,true,true);     WAIT_BAR(2); RESC(); ROT();
    STEP(pA0,pA1,pB0,pB1,t+1,true,true,true);   WAIT_BAR(2); RESC(); ROT();
  }
  #undef CMASK
  #define CMASK(P0,P1,t) do{int jb_=(t)-(NT-4); if(jb_>=0)cmask(P0,P1,jb_,qrel,hi);}while(0)
  #define ENDW(tt) do{ if((tt)+3<NT){WAIT_BAR(2);} else if((tt)+2<NT){WAIT_BAR(1);} else {WAIT_BAR(0);} }while(0)
  for(;t+1<NT;t+=2){
    STEP(pB0,pB1,pA0,pA1,t,(t+3<NT),(t+1<NT),(t+1<NT));       ENDW(t);   RESC(); ROT();
    STEP(pA0,pA1,pB0,pB1,t+1,(t+4<NT),(t+2<NT),(t+2<NT));     ENDW(t+1); RESC(); ROT();
  }
  STEP(pB0,pB1,pA0,pA1,NT-1,false,false,false); RESC();
  { float sacc=pB0[0]+pB0[1]; _Pragma("unroll") for(int r=2;r<16;++r)sacc+=pB0[r]; _Pragma("unroll") for(int r=0;r<16;++r)sacc+=pB1[r]; l_reg+=sacc;
    pw0=(u32x4){PKW(pB0,0),PKW(pB0,2),PKW(pB0,4),PKW(pB0,6)};pw1=(u32x4){PKW(pB0,8),PKW(pB0,10),PKW(pB0,12),PKW(pB0,14)};pw2=(u32x4){PKW(pB1,0),PKW(pB1,2),PKW(pB1,4),PKW(pB1,6)};pw3=(u32x4){PKW(pB1,8),PKW(pB1,10),PKW(pB1,12),PKW(pB1,14)};
    SBAR(); pv(o,vb0+sl_cur,PAF(0),PAF(1),PAF(2),PAF(3)); }
  #undef PKW
  #undef PAF
  #undef VFR
  #undef PIN
  #undef MX3
  #undef GAPA
  #undef GAPB
  #undef EX
  #undef VRD
  #undef KRD
  #undef STEP
  #undef ENDW
  {auto rr=__builtin_amdgcn_permlane32_swap(__float_as_uint(l_reg),__float_as_uint(l_reg),false,false);l_reg=__uint_as_float(rr[0])+__uint_as_float(rr[1]);}
  if(hi==0)wsf[32+r32]=l_reg;asm volatile("s_waitcnt lgkmcnt(0)":::"memory");
  float rli[16];
  #pragma unroll
  for(int r=0;r<16;++r)rli[r]=__builtin_amdgcn_rcpf(wsf[32+crow(r,hi)]);
  bf16*Ow=O+(rowbase+q0+wid*QBLK)*DM+ocol;
  { bf16*stg=(bf16*)(shm+((mode&1)?LDS_OST:LDS_STA))+wid*2048;
    #pragma unroll
    for(int r=0;r<16;++r){const int orow=crow(r,hi);
      #pragma unroll
      for(int d0=0;d0<2;++d0)stg[orow*64+d0*32+r32]=__float2bfloat16(o[d0][r]*rli[r]);}
    asm volatile("s_waitcnt lgkmcnt(0)":::"memory");
#ifndef ATT_NO_EPI2
    if(mode&1){ const bf16*sa=(const bf16*)(shm+LDS_STA)+wid*2048; bf16*sc=(bf16*)(shm+LDS_STC)+wid*2048;
      int ln=lane; asm volatile("":"+v"(ln));
      #pragma unroll 1
      for(int i=0;i<4;++i){const int row=i*8+(ln>>3),ch=ln&7,idx=row*64+ch*8; const u32x4 av=*(const u32x4*)(sa+idx),bv=*(const u32x4*)(stg+idx);
        float c[8];
        #pragma unroll
        for(int k=0;k<4;++k){ c[2*k]=__uint_as_float(av[k]<<16)-lam*__uint_as_float(bv[k]<<16); c[2*k+1]=__uint_as_float(av[k]&0xffff0000u)-lam*__uint_as_float(bv[k]&0xffff0000u); }
        if(mode==1){ u32x4 w; w[0]=cvtpk_s(c[0],c[1]);w[1]=cvtpk_s(c[2],c[3]);w[2]=cvtpk_s(c[4],c[5]);w[3]=cvtpk_s(c[6],c[7]); *(u32x4*)(sc+idx)=w; }
        else { const u32x4 cv=*(const u32x4*)(sc+idx); float c0[8];
          #pragma unroll
          for(int k=0;k<4;++k){ c0[2*k]=__uint_as_float(cv[k]<<16); c0[2*k+1]=__uint_as_float(cv[k]&0xffff0000u); }
          float ss=0.f;
          #pragma unroll
          for(int k=0;k<8;++k)ss+=c0[k]*c0[k]+c[k]*c[k];
          ss+=__shfl_xor(ss,1);ss+=__shfl_xor(ss,2);ss+=__shfl_xor(ss,4);
          const float rs=1.0f/sqrtf(ss*(1.0f/128.0f)+1e-6f);
          u32x4 w0,w1;
          w0[0]=cvtpk_s(c0[0]*rs,c0[1]*rs);w0[1]=cvtpk_s(c0[2]*rs,c0[3]*rs);w0[2]=cvtpk_s(c0[4]*rs,c0[5]*rs);w0[3]=cvtpk_s(c0[6]*rs,c0[7]*rs);
          w1[0]=cvtpk_s(c[0]*rs,c[1]*rs);w1[1]=cvtpk_s(c[2]*rs,c[3]*rs);w1[2]=cvtpk_s(c[4]*rs,c[5]*rs);w1[3]=cvtpk_s(c[6]*rs,c[7]*rs);
          *(u32x4*)(Ow+(long)row*DM+ch*8)=w0; *(u32x4*)(Ow+(long)row*DM+64+ch*8)=w1; }
      }
      asm volatile("s_waitcnt lgkmcnt(0)":::"memory");
    }
#endif
    }
  asm volatile("s_waitcnt lgkmcnt(0)\n\ts_barrier":::"memory");
  #undef DMA_K
  #undef DMA_V
  #undef CMASK
  #undef START
  #undef RESC
  #undef ROT
}
constexpr int ATTN_LDS_BYTES=LDS_BYTES;
#undef SBAR
#undef WAIT_BAR
}
constexpr int NWAVES = 8;
constexpr int TOK = 16384, DMODEL = 1024, NBATCH = 4, SEQL = 4096, MEMT = 1024  , DFF = 2816;
constexpr size_t MiB = 1u << 20;
constexpr size_t WS_CTL = 0, CTL_ZERO_BYTES = 1 * MiB;
constexpr size_t WS_RSTD0 = 1 * MiB, WS_RSTDM = WS_RSTD0 + 65536, WS_WAB = WS_RSTD0 + 131072, WS_GVAL = WS_RSTD0 + 262144, WS_BETA = WS_GVAL + 524288, WS_RCOS = WS_BETA + 524288, WS_RSIN = WS_RCOS + 524288;
constexpr size_t WS_SS1 = 4 * MiB, WS_SS2 = 5 * MiB, WS_SS3 = 6 * MiB, WS_KVC = 7 * MiB, WS_MEMB = 9 * MiB;
constexpr size_t WS_W1 = 11 * MiB, WS_WGZ = 23 * MiB, WS_WOUTA = 29 * MiB, WS_WOUTB = 31 * MiB, WS_WO = 33 * MiB, WS_WCQ = 35 * MiB, WS_WCKV = 36 * MiB, WS_WCO = 38 * MiB, WS_WFFI = 39 * MiB, WS_WFFO = 50 * MiB;
constexpr size_t WS_XB = 56 * MiB;
constexpr size_t WS_QB = 88 * MiB, WS_KB = 120 * MiB, WS_VB = 152 * MiB, WS_VA = 184 * MiB, WS_OA = 216 * MiB, WS_END = 256 * MiB;
constexpr size_t WS_X1 = 88 * MiB, WS_X1B = 152 * MiB, WS_MERGED = 184 * MiB, WS_QC = 216 * MiB, WS_OC = 232 * MiB, WS_ACT = 88 * MiB;
static_assert(WS_RSIN + 524288 <= WS_SS1 && WS_WFFO + (size_t)1024 * DFF * 2 <= WS_XB && WS_ACT + (size_t)TOK * DFF * 2 <= WS_VA && WS_OA + (size_t)TOK * 2048 <= WS_END - 8 * MiB, "d_ws map");
constexpr int CW_TMO = 0, CW_CODE = 1, CW_BAR = 4096, CW_QUEUE = 8192, CW_DBG = 8256;
constexpr int SCR_BYTES = 162816, LDSCTL_OFF = SCR_BYTES, MISC_OFF = LDSCTL_OFF + 320, LDS_BYTES = 163840;

#define GAS __attribute__((address_space(1)))
#define LAS __attribute__((address_space(3)))
typedef unsigned short bf16;
typedef unsigned v4u __attribute__((ext_vector_type(4)));
typedef unsigned v2u __attribute__((ext_vector_type(2)));
typedef float f32x4 __attribute__((ext_vector_type(4)));
typedef float f32x16 __attribute__((ext_vector_type(16)));
typedef short bf16x8 __attribute__((ext_vector_type(8)));
typedef short s16x4 __attribute__((ext_vector_type(4)));
#define GAS __attribute__((address_space(1)))
#define LAS __attribute__((address_space(3)))
typedef unsigned short bf16;
typedef unsigned v4u __attribute__((ext_vector_type(4)));
typedef float f32x4 __attribute__((ext_vector_type(4)));
typedef short bf16x8 __attribute__((ext_vector_type(8)));
typedef GAS unsigned gu32;
typedef GAS unsigned long long gu64;
#define RLX_AGENT __ATOMIC_RELAXED, __HIP_MEMORY_SCOPE_AGENT
#define LDS_WAIT() asm volatile("s_waitcnt lgkmcnt(0)" ::: "memory")
#define VM_WAIT() asm volatile("s_waitcnt vmcnt(0)" ::: "memory")
__device__ __forceinline__ unsigned long long rt() { return __builtin_amdgcn_s_memrealtime(); }
__device__ __forceinline__ unsigned f2bf(float f) { unsigned u = __builtin_bit_cast(unsigned, f); return (u + 0x7fffu + ((u >> 16) & 1u)) >> 16; }
__device__ __forceinline__ unsigned pk2(float lo, float hi) { return f2bf(lo) | (f2bf(hi) << 16); }

#define XB_TMO      128
#define XB_XCNT(j)  (256  + 64 * (j))
#define XB_XSUB(j)  (1280 + 64 * (j))
#define XB_XGEN(j)  (2304 + 64 * (j))
#define XB_TOP      3328
#define XB_TOPGEN   3392
#define XCD_BAR_WORDS 3456
#define XB_SPIN_CAP (1u << 18)

__device__ __forceinline__ unsigned xb_ld(unsigned* p)              { return __hip_atomic_load(p, __ATOMIC_RELAXED, __HIP_MEMORY_SCOPE_AGENT); }
__device__ __forceinline__ unsigned xb_add(unsigned* p, unsigned v) { return __hip_atomic_fetch_add(p, v, __ATOMIC_RELAXED, __HIP_MEMORY_SCOPE_AGENT); }
__device__ __forceinline__ unsigned xb_xcc_id() { return (unsigned)__builtin_amdgcn_s_getreg((3 << 11) | 20) & 0xFu; }
#define XB_SPIN(cond, bar) do { unsigned _sp = 0; while (cond) { __builtin_amdgcn_s_sleep(1); \
    if ((++_sp & 255u) == 0u) { if (xb_ld(&(bar)[XB_TMO])) break; if (_sp > XB_SPIN_CAP) { atomicAdd(&(bar)[XB_TMO], 1u); break; } } } } while (0)

struct XcdBarrier {
    unsigned* bar; unsigned x;
    volatile LAS unsigned* st;
};

__device__ __forceinline__ XcdBarrier xcd_barrier_post(unsigned* bar, volatile LAS unsigned* st, const bool t0) {
    XcdBarrier b; b.bar = bar; b.x = xb_xcc_id(); b.st = st;
    if (t0) (void)xb_add(&bar[XB_XCNT(b.x)], 1u);
    return b;
}
__device__ __forceinline__ void xcd_barrier_complete(unsigned* bar, unsigned x, unsigned& nloc, unsigned& nx) {
    const unsigned G = gridDim.x * gridDim.y * gridDim.z;
    unsigned sum, cnt, mine, sp = 0u;
    for (;;) {
        sum = 0u; cnt = 0u; mine = 0u;
#pragma unroll
        for (unsigned j = 0; j < 16; ++j) { const unsigned c = xb_ld(&bar[XB_XCNT(j)]); sum += c; cnt += (c > 0u) ? 1u : 0u; mine = (j == x) ? c : mine; }
        if (sum == G) break;
        __builtin_amdgcn_s_sleep(1);
        if ((++sp & 255u) == 0u) { if (xb_ld(&bar[XB_TMO])) break; if (sp > XB_SPIN_CAP) { atomicAdd(&bar[XB_TMO], 1u); break; } }
    }
    nloc = mine > 0u ? mine : 1u; nx = cnt > 0u ? cnt : 1u;
}

__device__ __forceinline__ void xcd_barrier(const XcdBarrier& b, const bool t0) {
    asm volatile("s_waitcnt vmcnt(0)" ::: "memory");
    __syncthreads();
    if (t0) {
        unsigned* bar = b.bar;
        __builtin_amdgcn_s_waitcnt(0);
        unsigned nloc = b.st[0], nx = b.st[1];
        if (nloc == 0u) { xcd_barrier_complete(bar, b.x, nloc, nx); b.st[0] = nloc; b.st[1] = nx; }
        const unsigned old = xb_add(&bar[XB_XSUB(b.x)], 1u);
        const unsigned gen = old / nloc;
        if (old + 1u == (gen + 1u) * nloc) {
            __builtin_amdgcn_fence(__ATOMIC_RELEASE, "agent");
            asm volatile("s_waitcnt vmcnt(0)" ::: "memory");
            const unsigned og = xb_add(&bar[XB_TOP], 1u);
            const unsigned tg = og / nx;
            if (og + 1u == (tg + 1u) * nx) xb_add(&bar[XB_TOPGEN], 1u);
            else XB_SPIN(xb_ld(&bar[XB_TOPGEN]) == tg, bar);
            __builtin_amdgcn_fence(__ATOMIC_ACQUIRE, "agent");
            xb_add(&bar[XB_XGEN(b.x)], 1u);
            asm volatile("s_waitcnt vmcnt(0)" ::: "memory");
        } else {
            XB_SPIN(xb_ld(&bar[XB_XGEN(b.x)]) == gen, bar);
            __builtin_amdgcn_fence(__ATOMIC_ACQUIRE, "agent");
            asm volatile("s_waitcnt vmcnt(0)" ::: "memory");
        }
    }
    __syncthreads();
}
struct Args { const void* in[27]; float* out; unsigned char* ws; float invf[8]; };
struct Frame {
    LAS unsigned char* lds; volatile LAS unsigned* MISC; gu32* ctl;
    int wave, vcu, G;
};
__device__ __forceinline__ float wave_sum(float v) {
#pragma unroll
    for (int o = 1; o < 64; o <<= 1) v += __shfl_xor(v, o);
    return v;
}
__device__ __forceinline__ unsigned pk2r(float lo, float hi) { typedef float f2 __attribute__((ext_vector_type(2))); typedef __bf16 b2 __attribute__((ext_vector_type(2))); f2 v = {lo, hi}; b2 b = __builtin_convertvector(v, b2); return __builtin_bit_cast(unsigned, b); }

__device__ __forceinline__ void tr_item(const float* W, int ldw, int scol0, int K, bf16* WT, int drow0, const float* gain, int gmask, float gscale, int mode, LAS float* scr, int item, int nblk, int lane) {
    const int kb = item / nblk, nb = item - kb * nblk, k0 = 64 * kb, n0 = 32 * nb;
    int sc = scol0 + n0;
    if (mode == 3) { const int j = n0 >> 8, wi = n0 & 255; sc = (wi < 128) ? j * 128 + wi : DFF + j * 128 + (wi - 128); }
#pragma unroll 8
    for (int i = 0; i < 32; ++i) { const int kk = 2 * i + (lane >> 5); const float g = gain ? gain[(k0 + kk) & gmask] * gscale : gscale; scr[kk * 33 + (lane & 31)] = W[(size_t)(k0 + kk) * ldw + sc + (lane & 31)] * g; }
    LDS_WAIT(); asm volatile("" ::: "memory");
    const int c = lane & 7;
#pragma unroll
    for (int j = 0; j < 4; ++j) { const int n = (lane >> 3) + 8 * j; const LAS float* s = scr + (8 * c) * 33 + n;
        v4u o; o.x = pk2r(s[0 * 33], s[1 * 33]); o.y = pk2r(s[2 * 33], s[3 * 33]); o.z = pk2r(s[4 * 33], s[5 * 33]); o.w = pk2r(s[6 * 33], s[7 * 33]);
        *(GAS v4u*)(WT + (size_t)(drow0 + n0 + n) * K + k0 + 8 * c) = o; }
    LDS_WAIT(); asm volatile("" ::: "memory");
}
#define TR_MAT(W, ldw, scol0, K, WT, drow0, nrows, gain, gmask, gscale, mode) do { const int nblk_ = (nrows) / 32, nit_ = ((K) / 64) * nblk_; \
    for (int it_ = (gw - base % NGW + NGW) % NGW; it_ < nit_; it_ += NGW) tr_item((W), (ldw), (scol0), (K), (WT), (drow0), (gain), (gmask), (gscale), (mode), scr, it_, nblk_, lane); base += nit_; } while (0)
__device__ __forceinline__ void row_to_bf16(const float* xrow, bf16* orow, float* rstd_out, int lane) {
    const GAS f32x4* xr = (const GAS f32x4*)xrow + lane; f32x4 v[4]; float s = 0.f;
#pragma unroll
    for (int j = 0; j < 4; ++j) { v[j] = xr[64 * j]; s += (v[j].x * v[j].x + v[j].y * v[j].y) + (v[j].z * v[j].z + v[j].w * v[j].w); }
    s = wave_sum(s);
    GAS v2u* o8 = (GAS v2u*)orow + lane;
#pragma unroll
    for (int j = 0; j < 4; ++j) { v2u w; w.x = pk2r(v[j].x, v[j].y); w.y = pk2r(v[j].z, v[j].w); o8[64 * j] = w; }
    if (lane == 0) *rstd_out = 1.0f / sqrtf(s * (1.0f / 1024.0f) + 1e-6f);
}
constexpr float C2Q = 0.125f * 1.4426950408889634f;
constexpr float C2X = 0.08838834764831845f * 1.4426950408889634f;
__device__ __forceinline__ void p0_prologue(Frame& F, const Args& A, unsigned char* ws) {
    LAS float* scr = (LAS float*)(F.lds + F.wave * 16384); const int lane = lane_id(), tid = F.wave * 64 + lane;
    const int gw = F.vcu * NWAVES + F.wave, NGW = F.G * NWAVES; int base = 0;
    const float* g_mix = (const float*)A.in[3]; const float* w_in = (const float*)A.in[4];
    TR_MAT(w_in, 7184, 0, 1024, (bf16*)(ws + WS_W1), 0, 3072, g_mix, 1023, 1.0f, 0);
    TR_MAT(w_in, 7184, 4112, 1024, (bf16*)(ws + WS_W1), 3072, 3072, g_mix, 1023, 1.0f, 0);
    TR_MAT((const float*)A.in[14], 2048, 0, 1024, (bf16*)(ws + WS_WGZ), 0, 2048, g_mix, 1023, 1.0f, 0);
    TR_MAT(w_in, 7184, 3072, 1024, (bf16*)(ws + WS_WGZ), 2048, 1024, g_mix, 1023, 1.0f, 0);
    TR_MAT((const float*)A.in[15], 1024, 0, 1024, (bf16*)(ws + WS_WOUTA), 0, 1024, (const float*)A.in[8], 127, 1.0f, 0);
    TR_MAT((const float*)A.in[16], 1024, 0, 1024, (bf16*)(ws + WS_WOUTB), 0, 1024, (const float*)A.in[13], 127, 0.8f, 0);
    TR_MAT((const float*)A.in[17], 1024, 0, 1024, (bf16*)(ws + WS_WO), 0, 1024, (const float*)nullptr, 0, 1.0f, 0);
    TR_MAT((const float*)A.in[20], 512, 0, 1024, (bf16*)(ws + WS_WCQ), 0, 512, (const float*)A.in[18], 1023, C2X, 0);
    TR_MAT((const float*)A.in[21], 1024, 0, 1024, (bf16*)(ws + WS_WCKV), 0, 1024, (const float*)A.in[19], 1023, 1.0f, 0);
    TR_MAT((const float*)A.in[22], 1024, 0, 512, (bf16*)(ws + WS_WCO), 0, 1024, (const float*)nullptr, 0, 1.0f, 0);
    TR_MAT((const float*)A.in[24], 2 * DFF, 0, 1024, (bf16*)(ws + WS_WFFI), 0, 2 * DFF, (const float*)A.in[23], 1023, 1.0f, 3);
    TR_MAT((const float*)A.in[25], 1024, 0, DFF, (bf16*)(ws + WS_WFFO), 0, 1024, (const float*)nullptr, 0, 1.0f, 0);
    const float* x = (const float*)A.in[0]; const float* mem = (const float*)A.in[1];
    for (int m = gw; m < TOK; m += NGW) row_to_bf16(x + (size_t)m * 1024, (bf16*)(ws + WS_XB) + (size_t)m * 1024, (float*)(ws + WS_RSTD0) + m, lane);
    for (int m = gw; m < MEMT; m += NGW) row_to_bf16(mem + (size_t)m * 1024, (bf16*)(ws + WS_MEMB) + (size_t)m * 1024, (float*)(ws + WS_RSTDM) + m, lane);
    const int gt = F.vcu * (NWAVES * 64) + tid, NGT = F.G * NWAVES * 64;
    const int* pos = (const int*)A.in[2];
    for (int i = gt; i < TOK * 8; i += NGT) { const float ang = (float)pos[i >> 3] * A.invf[i & 7]; double rev = (double)ang * 0.15915494309189535; rev -= (double)(long long)rev; const float rf = (float)rev;
        ((float*)(ws + WS_RCOS))[i] = __builtin_amdgcn_cosf(rf); ((float*)(ws + WS_RSIN))[i] = __builtin_amdgcn_sinf(rf); }
    for (int i = gt; i < 16 * 1024; i += NGT) { const int n = i >> 10, k = i & 1023; ((bf16*)(ws + WS_WAB))[i] = (bf16)(pk2r(w_in[(size_t)k * 7184 + 4096 + n] * g_mix[k], 0.f) & 0xffffu); }
}
__device__ __forceinline__ void ab_unit(Frame& F, const Args& A, unsigned char* ws, int mu) {
    typedef float f4 __attribute__((ext_vector_type(4)));
    const int rb = F.wave & 3, kh = F.wave >> 2, t0 = mu * 64, l = lane_id(), tid = F.wave * 64 + l;
    const bf16* xb = (const bf16*)(ws + WS_XB) + (size_t)(t0 + 16 * rb + (l & 15)) * 1024 + kh * 512 + 8 * (l >> 4);
    const bf16* wb = (const bf16*)(ws + WS_WAB) + (size_t)(l & 15) * 1024 + kh * 512 + 8 * (l >> 4);
    f4 acc = {0.f, 0.f, 0.f, 0.f};
#pragma unroll 4
    for (int ks = 0; ks < 16; ++ks) { const bf16x8 a = *(const bf16x8*)(xb + ks * 32), b = *(const bf16x8*)(wb + ks * 32); acc = __builtin_amdgcn_mfma_f32_16x16x32_bf16(a, b, acc, 0, 0, 0); }
    LAS float* red = (LAS float*)F.lds;
#pragma unroll
    for (int r = 0; r < 4; ++r) red[(kh * 4 + rb) * 256 + (4 * (l >> 4) + r) * 16 + (l & 15)] = acc[r];
    __syncthreads();
    const float* a_log = (const float*)A.in[6]; const float* dt_bias = (const float*)A.in[7];
#pragma unroll
    for (int j = 0; j < 2; ++j) { const int o = tid + 512 * j, row = o >> 4, col = o & 15;
        float v = red[(row >> 4) * 256 + (row & 15) * 16 + col] + red[(4 + (row >> 4)) * 256 + (row & 15) * 16 + col];
        v *= ((const float*)(ws + WS_RSTD0))[t0 + row];
        if (col < 8) { const float xx = v + dt_bias[col]; const float sp = xx > 20.f ? xx : log1pf(__expf(xx)); ((float*)(ws + WS_GVAL))[(size_t)(t0 + row) * 8 + col] = -__expf(a_log[col]) * sp; }
        else ((float*)(ws + WS_BETA))[(size_t)(t0 + row) * 8 + (col - 8)] = 1.0f / (1.0f + __expf(-v)); }
    __syncthreads();
}
__device__ __forceinline__ void final_rows(Frame& F, float* out, const float* ss3, const float* g_final) {
    const int gw = F.vcu * NWAVES + F.wave, NGW = F.G * NWAVES, lane = lane_id();
    f32x4 g[4];
#pragma unroll
    for (int j = 0; j < 4; ++j) g[j] = *((const GAS f32x4*)g_final + lane + 64 * j);
    for (int m = gw; m < TOK; m += NGW) { const float rs = pg8::rstd16(ss3 + (size_t)m * 16); GAS f32x4* o = (GAS f32x4*)(out + (size_t)m * 1024) + lane;
#pragma unroll
        for (int j = 0; j < 4; ++j) { const f32x4 v = o[64 * j]; o[64 * j] = v * rs * g[j]; } }
}
namespace gdn {
constexpr int L_RV = 0, L_RK = 32768, L_LM = 65536, L_KN = 81920, L_QN = 98304, L_QD = 114688, L_KDT = 131072, L_AT = 147456, L_GC = 155648, L_BYTES = 156672;
static_assert(L_BYTES <= SCR_BYTES, "gdn LDS");
__device__ __forceinline__ int sw256(int row, int chunk) { return row * 256 + ((chunk ^ (row & 15)) << 4); }
__device__ __forceinline__ int sw128(int row, int chunk) { return row * 128 + ((chunk ^ ((row >> 1) & 7)) << 4); }
__device__ __forceinline__ int crow(int r, int hi) { return (r & 3) + 8 * (r >> 2) + 4 * hi; }
__device__ __forceinline__ bf16x8 frag2(const LAS unsigned char* tile, int off0, int off1) { const v2u a = *(const LAS v2u*)(tile + off0), b = *(const LAS v2u*)(tile + off1); v4u w = {a.x, a.y, b.x, b.y}; return __builtin_bit_cast(bf16x8, w); }
__device__ __forceinline__ bf16x8 packacc(const f32x16& v, int s) { v4u w; w.x = pk2r(v[8 * s + 0], v[8 * s + 1]); w.y = pk2r(v[8 * s + 2], v[8 * s + 3]); w.z = pk2r(v[8 * s + 4], v[8 * s + 5]); w.w = pk2r(v[8 * s + 6], v[8 * s + 7]); return __builtin_bit_cast(bf16x8, w); }
__device__ __forceinline__ float siluf_(float x) { return x / (1.0f + __expf(-x)); }

__device__ __forceinline__ void gdn_block(Frame& F, const Args& A, unsigned char* ws, float* dout, int b, int h) {
    LAS unsigned char* L = F.lds; const int wave = F.wave;
    const bf16* QA = (const bf16*)dout; const bf16* KA = (const bf16*)dout + (size_t)TOK * 1024; const bf16* VA = (const bf16*)(ws + WS_VA);
    bf16* OA = (bf16*)(ws + WS_OA);
    const float* conv_w = (const float*)A.in[5]; const float* gval = (const float*)(ws + WS_GVAL); const float* beta = (const float*)(ws + WS_BETA);
    LAS float* RV = (LAS float*)(L + L_RV); LAS float* RK = (LAS float*)(L + L_RK); LAS float* LM = (LAS float*)(L + L_LM); LAS float* GC = (LAS float*)(L + L_GC);
    f32x16 S[4];
#pragma unroll
    for (int i = 0; i < 4; ++i) S[i] = (f32x16){};
    for (int ch = 0; ch < SEQL / 64; ++ch) {
        const int tb0 = ch * 64; const size_t grow0 = (size_t)b * SEQL + tb0;
        int lv = lane_id(); asm volatile("" : "+v"(lv));
        const int hi = lv >> 5, r32 = lv & 31;
        const int l = lv; float gcs = gval[(grow0 + l) * 8 + h];
#pragma unroll
        for (int o = 1; o < 64; o <<= 1) { const float t = __shfl_up(gcs, o); if (l >= o) gcs += t; }
        const float glast = __shfl(gcs, 63); const float egc_l = __expf(gcs), ekd_l = __expf(glast - gcs), bt_l = beta[(grow0 + l) * 8 + h];
        if (wave == 0) { GC[l] = gcs; GC[64 + l] = egc_l; GC[128 + l] = ekd_l; GC[192 + l] = bt_l; }
#ifndef GDN_NO_E
        const int g = lv & 15, r0 = (wave << 2) + (lv >> 4);
#pragma unroll
        for (int half = 0; half < 2; ++half) { const int c = r0 + 32 * half; const float egc = __shfl(egc_l, c), ekd = __shfl(ekd_l, c), bt = __shfl(bt_l, c);
#pragma unroll
            for (int X = 0; X < 3; ++X) { const bf16* src = (X == 0 ? QA : X == 1 ? KA : VA) + (grow0 + c) * 1024 + h * 128 + 8 * g; const float* cw = conv_w + X * 1024 + h * 128 + 8 * g;
                float o[8];
#pragma unroll
                for (int e = 0; e < 8; ++e) o[e] = 0.f;
#pragma unroll
                for (int jj = 0; jj < 4; ++jj) { v4u raw = {0u, 0u, 0u, 0u}; if (tb0 + c - 3 + jj >= 0) raw = *(const GAS v4u*)(src + (jj - 3) * 1024);
                    const f32x4 w0 = *(const GAS f32x4*)(cw + jj * 3072), w1 = *(const GAS f32x4*)(cw + jj * 3072 + 4);
                    o[0] += w0[0] * __uint_as_float(raw.x << 16); o[1] += w0[1] * __uint_as_float(raw.x & 0xffff0000u); o[2] += w0[2] * __uint_as_float(raw.y << 16); o[3] += w0[3] * __uint_as_float(raw.y & 0xffff0000u);
                    o[4] += w1[0] * __uint_as_float(raw.z << 16); o[5] += w1[1] * __uint_as_float(raw.z & 0xffff0000u); o[6] += w1[2] * __uint_as_float(raw.w << 16); o[7] += w1[3] * __uint_as_float(raw.w & 0xffff0000u); }
                float ss = 0.f;
#pragma unroll
                for (int e = 0; e < 8; ++e) { o[e] = siluf_(o[e]); ss += o[e] * o[e]; }
                if (X < 2) { ss += __shfl_xor(ss, 1); ss += __shfl_xor(ss, 2); ss += __shfl_xor(ss, 4); ss += __shfl_xor(ss, 8); const float rn = 1.0f / sqrtf(ss + 1e-6f) * (X == 0 ? 0.08838834764831845f : 1.0f);
#pragma unroll
                    for (int e = 0; e < 8; ++e) o[e] *= rn; }
                if (X == 0) { v4u w = {pk2r(o[0], o[1]), pk2r(o[2], o[3]), pk2r(o[4], o[5]), pk2r(o[6], o[7])}; *(LAS v4u*)(L + L_QN + sw256(c, g)) = w;
                    v4u wd = {pk2r(o[0] * egc, o[1] * egc), pk2r(o[2] * egc, o[3] * egc), pk2r(o[4] * egc, o[5] * egc), pk2r(o[6] * egc, o[7] * egc)}; *(LAS v4u*)(L + L_QD + sw256(c, g)) = wd; }
                else if (X == 1) { v4u w = {pk2r(o[0], o[1]), pk2r(o[2], o[3]), pk2r(o[4], o[5]), pk2r(o[6], o[7])}; *(LAS v4u*)(L + L_KN + sw256(c, g)) = w;
#pragma unroll
                    for (int e = 0; e < 8; ++e) *(LAS bf16*)(L + L_KDT + sw128(8 * g + e, c >> 3) + (c & 7) * 2) = (bf16)(pk2r(o[e] * ekd, 0.f) & 0xffffu);
                    const float f = bt * egc; *(LAS f32x4*)(RK + c * 128 + 8 * g) = (f32x4){o[0] * f, o[1] * f, o[2] * f, o[3] * f}; *(LAS f32x4*)(RK + c * 128 + 8 * g + 4) = (f32x4){o[4] * f, o[5] * f, o[6] * f, o[7] * f}; }
                else { *(LAS f32x4*)(RV + c * 128 + 8 * g) = (f32x4){o[0] * bt, o[1] * bt, o[2] * bt, o[3] * bt}; *(LAS f32x4*)(RV + c * 128 + 8 * g + 4) = (f32x4){o[4] * bt, o[5] * bt, o[6] * bt, o[7] * bt}; } } }
#endif
        __syncthreads();
#ifndef GDN_NO_M
        if (wave < 6) { const bool isL = wave < 3; const int j = isL ? wave : wave - 3; const int ab = isL ? (j >= 1) : (j == 2), bb = isL ? (j == 2) : (j >= 1);
            const int arow = 32 * ab + r32, brow = 32 * bb + r32; const LAS unsigned char* At = L + L_KN; const LAS unsigned char* Bt = L + (isL ? L_KN : L_QN);
            f32x16 acc = {};
#pragma unroll
            for (int s = 0; s < 8; ++s) { const bf16x8 a = *(const LAS bf16x8*)(At + sw256(arow, 2 * s + hi)), bq = *(const LAS bf16x8*)(Bt + sw256(brow, 2 * s + hi)); acc = __builtin_amdgcn_mfma_f32_32x32x16_bf16(a, bq, acc, 0, 0, 0); }
            if (isL) { const int m = brow; const float gm = GC[m];
#pragma unroll
                for (int r = 0; r < 16; ++r) { const int c = 32 * ab + crow(r, hi); const float d = fminf(GC[c] - gm, 0.f); LM[c * 64 + m] = (c > m) ? acc[r] * GC[192 + c] * __expf(d) : 0.f; } }
            else { const int c = brow; const float gcc = GC[c];
#pragma unroll
                for (int g4 = 0; g4 < 4; ++g4) { float v[4];
#pragma unroll
                    for (int e = 0; e < 4; ++e) { const int m = 32 * ab + 8 * g4 + 4 * hi + e; const float d = fminf(gcc - GC[m], 0.f); v[e] = (c >= m) ? acc[4 * g4 + e] * __expf(d) : 0.f; }
                    v2u w = {pk2r(v[0], v[1]), pk2r(v[2], v[3])}; *(LAS v2u*)(L + L_AT + sw128(c, 4 * ab + g4) + 8 * hi) = w; } } }
#endif
        __syncthreads();
#ifndef GDN_NO_S
        if (wave < 4) { LAS float* R = (wave < 2) ? RV : RK; const int col = 64 * (wave & 1) + lv; float x[64];
#pragma unroll
            for (int c = 0; c < 64; ++c) x[c] = R[c * 128 + col];
            int lmb = L_LM + (lv & 0); asm volatile("" : "+v"(lmb));
#pragma unroll
            for (int i = 1; i < 64; ++i) { float acc = x[i]; const LAS f32x4* lr = (const LAS f32x4*)(L + lmb + i * 256); if ((i & 3) == 0) asm volatile("" ::: "memory");
#pragma unroll
                for (int m4 = 0; m4 * 4 < i; ++m4) { const f32x4 lq = lr[m4];
                    if (4 * m4 + 0 < i) acc -= lq[0] * x[4 * m4 + 0];
                    if (4 * m4 + 1 < i) acc -= lq[1] * x[4 * m4 + 1];
                    if (4 * m4 + 2 < i) acc -= lq[2] * x[4 * m4 + 2];
                    if (4 * m4 + 3 < i) acc -= lq[3] * x[4 * m4 + 3]; }
                x[i] = acc; }
            if (wave < 2) {
#pragma unroll
                for (int c = 0; c < 64; ++c) R[c * 128 + col] = x[c]; }
            else {
#pragma unroll
                for (int c = 0; c < 64; ++c) *(LAS bf16*)(L + L_KN + sw256(c, col >> 3) + (col & 7) * 2) = (bf16)(pk2r(-x[c], 0.f) & 0xffffu); } }
#endif
        __syncthreads();
#ifndef GDN_NO_SCAN
        if (wave < 4) { const int dvb = wave; const float eg = __expf(GC[63]);
            f32x16 av[2], ao[2];
#pragma unroll
            for (int cb = 0; cb < 2; ++cb) { ao[cb] = (f32x16){};
#pragma unroll
                for (int r = 0; r < 16; ++r) av[cb][r] = RV[(32 * cb + crow(r, hi)) * 128 + 32 * dvb + r32]; }
#pragma unroll
            for (int d = 0; d < 4; ++d)
#pragma unroll
                for (int s = 0; s < 2; ++s) { const bf16x8 sbf = packacc(S[d], s); const int c0 = 4 * d + 2 * s;
#pragma unroll
                    for (int cb = 0; cb < 2; ++cb) { const int row = 32 * cb + r32;
                        av[cb] = __builtin_amdgcn_mfma_f32_32x32x16_bf16(frag2(L + L_KN, sw256(row, c0) + 8 * hi, sw256(row, c0 + 1) + 8 * hi), sbf, av[cb], 0, 0, 0);
                        ao[cb] = __builtin_amdgcn_mfma_f32_32x32x16_bf16(frag2(L + L_QD, sw256(row, c0) + 8 * hi, sw256(row, c0 + 1) + 8 * hi), sbf, ao[cb], 0, 0, 0); } }
            bf16x8 vb[2][2];
#pragma unroll
            for (int mb = 0; mb < 2; ++mb) { vb[mb][0] = packacc(av[mb], 0); vb[mb][1] = packacc(av[mb], 1); }
#pragma unroll
            for (int cb = 0; cb < 2; ++cb) { const int row = 32 * cb + r32;
#pragma unroll
                for (int mb = 0; mb <= cb; ++mb)
#pragma unroll
                    for (int s = 0; s < 2; ++s) { const int c0 = 4 * mb + 2 * s; ao[cb] = __builtin_amdgcn_mfma_f32_32x32x16_bf16(frag2(L + L_AT, sw128(row, c0) + 8 * hi, sw128(row, c0 + 1) + 8 * hi), vb[mb][s], ao[cb], 0, 0, 0); } }
#pragma unroll
            for (int d = 0; d < 4; ++d) { const int row = 32 * d + r32; S[d] = S[d] * eg;
#pragma unroll
                for (int mb = 0; mb < 2; ++mb)
#pragma unroll
                    for (int s = 0; s < 2; ++s) { const int c0 = 4 * mb + 2 * s; S[d] = __builtin_amdgcn_mfma_f32_32x32x16_bf16(frag2(L + L_KDT, sw128(row, c0) + 8 * hi, sw128(row, c0 + 1) + 8 * hi), vb[mb][s], S[d], 0, 0, 0); } }
#pragma unroll
            for (int cb = 0; cb < 2; ++cb)
#pragma unroll
                for (int r = 0; r < 16; ++r) RK[(32 * cb + crow(r, hi)) * 128 + 32 * dvb + r32] = ao[cb][r]; }
#endif
        __syncthreads();
#pragma unroll
        for (int i = 0; i < 8; ++i) { const int c = 8 * wave + i; const LAS float* op = RK + c * 128 + 2 * l; const float a = op[0], bq = op[1]; const float ss = wave_sum(a * a + bq * bq); const float rs = 1.0f / sqrtf(ss * (1.0f / 128.0f) + 1e-6f);
            *(GAS unsigned*)(OA + (grow0 + c) * 1024 + h * 128 + 2 * l) = pk2r(a * rs, bq * rs); }
        __syncthreads();
    }
}
}
namespace xat {
constexpr int L_KC = 0, L_VT = 65536, L_WS = 131072, L_BYTES = 131072 + 8 * 256;
__device__ __forceinline__ int swVT(int row, int chunk) { return row * 512 + ((chunk ^ (row & 31)) << 4); }
__device__ __forceinline__ void unit(Frame& F, unsigned char* ws, int pm, int hd) {
    LAS unsigned char* L = F.lds; const int wave = F.wave, l = lane_id(), tid = wave * 64 + l, hi = l >> 5, r32 = l & 31;
    const bf16* QC = (const bf16*)(ws + WS_QC); const bf16* KVC = (const bf16*)(ws + WS_KVC); bf16* OC = (bf16*)(ws + WS_OC);
    const int b = pm >> 4; const size_t row0 = (size_t)pm * 256 + wave * 32;
#pragma unroll
    for (int i = 0; i < 8; ++i) { const int id = tid + 512 * i, key = id >> 4, ch = id & 15; const bf16* kp = KVC + (size_t)(b * 256 + key) * 1024 + hd * 128 + 8 * ch;
        *(LAS v4u*)(L + L_KC + gdn::sw256(key, ch)) = *(const GAS v4u*)kp;
        const v4u vv = *(const GAS v4u*)(kp + 512);
#pragma unroll
        for (int e = 0; e < 4; ++e) { const unsigned w = vv[e]; const int dv = 8 * ch + 2 * e;
            *(LAS bf16*)(L + L_VT + swVT(dv, key >> 3) + (key & 7) * 2) = (bf16)(w & 0xffffu); *(LAS bf16*)(L + L_VT + swVT(dv + 1, key >> 3) + (key & 7) * 2) = (bf16)(w >> 16); } }
    bf16x8 qr[8];
#pragma unroll
    for (int s = 0; s < 8; ++s) qr[s] = *(const GAS bf16x8*)(QC + (row0 + r32) * 512 + hd * 128 + 16 * s + 8 * hi);
    __syncthreads();
    LAS float* wsf = (LAS float*)(L + L_WS + wave * 256);
    f32x16 O[4];
#pragma unroll
    for (int d = 0; d < 4; ++d) O[d] = (f32x16){};
    float mrun = -1e30f, lrun = 0.f;
    for (int kt = 0; kt < 4; ++kt) {
        f32x16 p[2];
#pragma unroll
        for (int j = 0; j < 2; ++j) { p[j] = (f32x16){}; const int key = 64 * kt + 32 * j + r32;
#pragma unroll
            for (int s = 0; s < 8; ++s) p[j] = __builtin_amdgcn_mfma_f32_32x32x16_bf16(*(const LAS bf16x8*)(L + L_KC + gdn::sw256(key, 2 * s + hi)), qr[s], p[j], 0, 0, 0); }
        float tm = p[0][0];
#pragma unroll
        for (int r = 0; r < 16; ++r) tm = fmaxf(tm, fmaxf(p[0][r], p[1][r]));
        tm = fmaxf(tm, __shfl_xor(tm, 32));
        const float mn = fmaxf(mrun, tm), alpha = __builtin_amdgcn_exp2f(mrun - mn); mrun = mn;
        float ls = 0.f;
#pragma unroll
        for (int j = 0; j < 2; ++j)
#pragma unroll
            for (int r = 0; r < 16; ++r) { p[j][r] = __builtin_amdgcn_exp2f(p[j][r] - mn); ls += p[j][r]; }
        lrun = lrun * alpha + ls;
        if (hi == 0) wsf[r32] = alpha;
        LDS_WAIT(); asm volatile("" ::: "memory");
#pragma unroll
        for (int r = 0; r < 16; ++r) { const float a = wsf[gdn::crow(r, hi)];
#pragma unroll
            for (int d = 0; d < 4; ++d) O[d][r] *= a; }
#pragma unroll
        for (int j = 0; j < 2; ++j)
#pragma unroll
            for (int s = 0; s < 2; ++s) { const bf16x8 af = gdn::packacc(p[j], s); const int c0 = 8 * kt + 4 * j + 2 * s;
#pragma unroll
                for (int d = 0; d < 4; ++d) { const int dv = 32 * d + r32; O[d] = __builtin_amdgcn_mfma_f32_32x32x16_bf16(af, gdn::frag2(L + L_VT, swVT(dv, c0) + 8 * hi, swVT(dv, c0 + 1) + 8 * hi), O[d], 0, 0, 0); } }
        LDS_WAIT(); asm volatile("" ::: "memory");
    }
    lrun += __shfl_xor(lrun, 32);
    if (hi == 0) wsf[32 + r32] = 1.0f / lrun;
    LDS_WAIT(); asm volatile("" ::: "memory");
#pragma unroll
    for (int r = 0; r < 16; ++r) { const int q = gdn::crow(r, hi); const float il = wsf[32 + q];
#pragma unroll
        for (int d = 0; d < 4; ++d) OC[(row0 + q) * 512 + hd * 128 + 32 * d + r32] = (bf16)(pk2r(O[d][r] * il, 0.f) & 0xffffu); }
    __syncthreads();
}
}
#ifndef USE_CG
#define USE_CG 1
#endif
#ifndef PH_LAST
#define PH_LAST 99
#endif
__global__ void __launch_bounds__(NWAVES * 64, 2) fwd_megakernel(Args args) {
    extern __shared__ __attribute__((aligned(16))) unsigned char lds[];
    Frame F;
    F.lds = (LAS unsigned char*)lds; F.MISC = (volatile LAS unsigned*)(F.lds + MISC_OFF);
    F.wave = __builtin_amdgcn_readfirstlane((int)threadIdx.x >> 6);
    const bool t0 = (threadIdx.x == 0);
    F.G = gridDim.x; { const int bx = blockIdx.x; F.vcu = (F.G % 8 == 0) ? (bx % 8) * (F.G / 8) + bx / 8 : bx; }
    unsigned char* ws = args.ws; float* dout = args.out;
    F.ctl = (gu32*)(ws + WS_CTL);
    for (int u = F.wave * 64 + lane_id(); u < (LDS_BYTES - LDSCTL_OFF) / 4; u += NWAVES * 64) ((LAS unsigned*)(F.lds + LDSCTL_OFF))[u] = 0u;
    __syncthreads();
#if USE_CG
    cg::grid_group grid = cg::this_grid();
#define GRID_BAR() grid.sync()
#else
    XcdBarrier bar = xcd_barrier_post((unsigned*)(F.ctl + CW_BAR), F.MISC + 8, t0);
#define GRID_BAR() xcd_barrier(bar, F.wave == 0 && lane_id() == 0)
#endif
    const int c = (int)blockIdx.x, G = F.G;
    constexpr int NOSPLIT = 1 << 30;
    LAS unsigned char* ring = F.lds;

    p0_prologue(F, args, ws);
    GRID_BAR();
#if PH_LAST >= 1
    for (int mu = c; mu < TOK / 64; mu += G) ab_unit(F, args, ws, mu);
    {   pg8::Gemm g{(const pg8::bf16_t*)(ws + WS_XB), (const pg8::bf16_t*)(ws + WS_W1), TOK, 6144, 1024, NOSPLIT, 0L}; pg8::StaticOrder S; S.init(TOK, 6144, G, c);
        pg8::EpiP1 E{(pg8::bf16_t*)dout, (pg8::bf16_t*)dout + (size_t)TOK * 1024, (pg8::bf16_t*)(ws + WS_VA), (pg8::bf16_t*)(ws + WS_QB), (pg8::bf16_t*)(ws + WS_KB), (pg8::bf16_t*)(ws + WS_VB),
                     (const float*)(ws + WS_RSTD0), (const float*)(ws + WS_RCOS), (const float*)(ws + WS_RSIN), C2Q};
        pg8::gemm_phase<pg8::EpiP1, pg8::StaticOrder, true, true>(ring, g, S, E, F.wave); }
    GRID_BAR();
#endif
#if PH_LAST >= 2
    {
#ifndef NO_GDN
        if (c < 32) gdn::gdn_block(F, args, ws, dout, c >> 3, c & 7);
#endif
        float s1 = 0.f, s2 = 0.f; { const float* q1 = (const float*)args.in[9]; const float* k1 = (const float*)args.in[10]; const float* q2 = (const float*)args.in[11]; const float* k2 = (const float*)args.in[12];
            for (int i = 0; i < 64; ++i) { s1 += q1[i] * k1[i]; s2 += q2[i] * k2[i]; } }
        const float lam = __uint_as_float((unsigned)__builtin_amdgcn_readfirstlane((int)__float_as_uint(expf(s1) - expf(s2) + 0.2f)));
        const attn_body::bf16* QBp = (const attn_body::bf16*)(ws + WS_QB); const attn_body::bf16* KBp = (const attn_body::bf16*)(ws + WS_KB); const attn_body::bf16* VBp = (const attn_body::bf16*)(ws + WS_VB);
#ifndef NO_ATTN
        for (;;) {
            int moff = MISC_OFF + 64; asm volatile("" : "+v"(moff));
            volatile LAS unsigned* qw = (volatile LAS unsigned*)(F.lds + moff);
            if (F.wave == 0 && lane_id() == 0) *qw = __hip_atomic_fetch_add((unsigned*)(F.ctl + CW_QUEUE), 1u, __ATOMIC_RELAXED, __HIP_MEMORY_SCOPE_AGENT);
            __syncthreads(); const unsigned idx = (unsigned)__builtin_amdgcn_readfirstlane((int)*qw); __syncthreads();
            if (idx >= 512u) break;
            const int b = (idx & 31) >> 3, h = idx & 7, qb = 15 - (int)(idx >> 5);
            for (int mode = 0; mode < 4; ++mode)
                attn_body::attn_unit<8>(b, (2 * h + (mode & 1)) * 64, h * 128 + (mode >> 1) * 64, h * 128, qb, mode, lam, QBp, KBp, VBp, (attn_body::bf16*)(ws + WS_QB), (char*)lds, F.wave);
        }
#endif
        (void)lam; (void)QBp; (void)KBp; (void)VBp; }
    GRID_BAR();
#endif
#if PH_LAST >= 3
    {   pg8::Gemm g{(const pg8::bf16_t*)(ws + WS_XB), (const pg8::bf16_t*)(ws + WS_WGZ), TOK, 3072, 1024, NOSPLIT, 0L}; pg8::StaticOrder S; S.init(TOK, 3072, G, c);
        pg8::EpiP3a E{(pg8::bf16_t*)dout, (pg8::bf16_t*)(ws + WS_OA), (const float*)(ws + WS_RSTD0)};
        pg8::gemm_phase<pg8::EpiP3a, pg8::StaticOrder, true, true>(ring, g, S, E, F.wave); }
    GRID_BAR();
    {   pg8::Gemm g{(const pg8::bf16_t*)(ws + WS_OA), (const pg8::bf16_t*)(ws + WS_WOUTA), TOK, 2048, 1024, 4, (long)WS_QB - (long)WS_OA}; pg8::PairOrder S; S.init(TOK, G, c);
        pg8::EpiP3b E{(const pg8::bf16_t*)dout, (pg8::bf16_t*)(ws + WS_MERGED)};
        pg8::gemm_phase<pg8::EpiP3b, pg8::PairOrder, true, true>(ring, g, S, E, F.wave); }
    GRID_BAR();
#endif
#if PH_LAST >= 4
    {   pg8::Gemm g{(const pg8::bf16_t*)(ws + WS_MERGED), (const pg8::bf16_t*)(ws + WS_WO), TOK, 1024, 1024, NOSPLIT, 0L}; pg8::StaticOrder S; S.init(TOK, 1024, G, c);
        pg8::EpiRes E{(const float*)args.in[0], (float*)(ws + WS_X1), (pg8::bf16_t*)(ws + WS_X1B), (float*)(ws + WS_SS1)};
        pg8::gemm_phase<pg8::EpiRes, pg8::StaticOrder, true, true>(ring, g, S, E, F.wave); }
    GRID_BAR();
#endif
#if PH_LAST >= 5
    {   pg8::Gemm g{(const pg8::bf16_t*)(ws + WS_X1B), (const pg8::bf16_t*)(ws + WS_WCQ), TOK, 512, 1024, NOSPLIT, 0L}; pg8::StaticOrder S; S.init(TOK, 512, G, c);
        pg8::EpiRowBf16 E{(pg8::bf16_t*)(ws + WS_QC), 512, nullptr, (const float*)(ws + WS_SS1)};
        pg8::gemm_phase<pg8::EpiRowBf16, pg8::StaticOrder, true, true>(ring, g, S, E, F.wave); }
    {   pg8::Gemm g{(const pg8::bf16_t*)(ws + WS_MEMB), (const pg8::bf16_t*)(ws + WS_WCKV), MEMT, 1024, 1024, NOSPLIT, 0L}; pg8::StaticOrder S; S.init(MEMT, 1024, G, (c + G - (128 % G)) % G);
        pg8::EpiRowBf16 E{(pg8::bf16_t*)(ws + WS_KVC), 1024, (const float*)(ws + WS_RSTDM), nullptr};
        pg8::gemm_phase<pg8::EpiRowBf16, pg8::StaticOrder, true, true>(ring, g, S, E, F.wave); }
    GRID_BAR();
    for (int u = c; u < (TOK / 256) * 4; u += G) xat::unit(F, ws, u >> 2, u & 3);
    GRID_BAR();
#endif
#if PH_LAST >= 6
    {   pg8::Gemm g{(const pg8::bf16_t*)(ws + WS_OC), (const pg8::bf16_t*)(ws + WS_WCO), TOK, 1024, 512, NOSPLIT, 0L}; pg8::StaticOrder S; S.init(TOK, 1024, G, c);
        pg8::EpiRes E{(const float*)(ws + WS_X1), dout, (pg8::bf16_t*)(ws + WS_XB), (float*)(ws + WS_SS2)};
        pg8::gemm_phase<pg8::EpiRes, pg8::StaticOrder, true, true>(ring, g, S, E, F.wave); }
    GRID_BAR();
#endif
#if PH_LAST >= 7
    {   pg8::Gemm g{(const pg8::bf16_t*)(ws + WS_XB), (const pg8::bf16_t*)(ws + WS_WFFI), TOK, 2 * DFF, 1024, NOSPLIT, 0L}; pg8::StaticOrder S; S.init(TOK, 2 * DFF, G, c);
        pg8::EpiAct E{(pg8::bf16_t*)(ws + WS_ACT), (const float*)(ws + WS_SS2)};
        pg8::gemm_phase<pg8::EpiAct, pg8::StaticOrder, true, true>(ring, g, S, E, F.wave); }
    GRID_BAR();
#endif
#if PH_LAST >= 8
    {   pg8::Gemm g{(const pg8::bf16_t*)(ws + WS_ACT), (const pg8::bf16_t*)(ws + WS_WFFO), TOK, 1024, DFF, NOSPLIT, 0L}; pg8::StaticOrder S; S.init(TOK, 1024, G, c);
        pg8::EpiRes E{dout, dout, nullptr, (float*)(ws + WS_SS3)};
        pg8::gemm_phase<pg8::EpiRes, pg8::StaticOrder, true, true>(ring, g, S, E, F.wave); }
    GRID_BAR();
    final_rows(F, dout, (const float*)(ws + WS_SS3), (const float*)args.in[26]);
#endif
}

extern "C" void kernel_launch(void* const* d_in, const int* in_sizes, int n_in, void* d_out, int out_size, void* d_ws, size_t ws_size, hipStream_t stream) {
    static int grid = 0;
    if (grid == 0) {
        if (n_in != 27 || out_size != TOK * DMODEL || ws_size < WS_END) { fprintf(stderr, "kernel_launch: unexpected problem shape (n_in %d, out %d, ws %zu); nothing launched\n", n_in, out_size, ws_size); grid = -1; return; }
        int dev = 0, cus = 0, per_cu = 0;
        if (hipGetDevice(&dev) != hipSuccess || hipDeviceGetAttribute(&cus, hipDeviceAttributeMultiprocessorCount, dev) != hipSuccess) { grid = -1; return; }
        if (hipFuncSetAttribute((const void*)fwd_megakernel, hipFuncAttributeMaxDynamicSharedMemorySize, LDS_BYTES) != hipSuccess) { fprintf(stderr, "kernel_launch: hipFuncSetAttribute failed\n"); grid = -1; return; }
        if (hipOccupancyMaxActiveBlocksPerMultiprocessor(&per_cu, (const void*)fwd_megakernel, NWAVES * 64, LDS_BYTES) != hipSuccess || per_cu < 1) { fprintf(stderr, "kernel_launch: occupancy query reports %d workgroups per CU\n", per_cu); per_cu = 1; }
        (void)hipGetLastError();
        grid = cus;
        if (grid != 256) fprintf(stderr, "kernel_launch: %d CUs (tuned for 256)\n", grid);
    }
    if (grid < 0) return;
    (void)hipMemsetAsync((char*)d_ws + WS_CTL, 0, CTL_ZERO_BYTES, stream);
    Args a{};
    for (int i = 0; i < 27; ++i) a.in[i] = d_in[i];
    a.out = (float*)d_out; a.ws = (unsigned char*)d_ws;
    for (int i = 0; i < 8; ++i) a.invf[i] = powf(500000.0f, -(float)(2 * i) / 16.0f);
    void* kargs[] = {&a};
    const hipError_t e = hipLaunchCooperativeKernel((const void*)fwd_megakernel, dim3(grid), dim3(NWAVES * 64), kargs, LDS_BYTES, stream);
    if (e != hipSuccess) fprintf(stderr, "kernel_launch: cooperative launch failed: %s (grid %d)\n", hipGetErrorString(e), grid);
}
```

```cpp
#include <hip/hip_runtime.h>
#include <hip/hip_bf16.h>
#include <hip/hip_cooperative_groups.h>
#include <cstdio>
#include <cstdint>
#include <cmath>
#include <utility>
namespace cg = cooperative_groups;
#ifndef TPROBE
#define TPROBE -1
#endif
#ifndef DBG
#define DBG 0
#endif
__device__ __forceinline__ int lane_id() { int x; asm volatile("v_mbcnt_lo_u32_b32 %0, -1, 0\n\tv_mbcnt_hi_u32_b32 %0, -1, %0" : "=v"(x)); return x; }
__device__ __forceinline__ int fresh_s(int v) { asm volatile("" : "+s"(v)); return v; }
namespace pg8 {
#define PG8_LAS __attribute__((address_space(3)))
typedef unsigned short bf16_t;
typedef short bf16x8 __attribute__((ext_vector_type(8)));
typedef float f32x4 __attribute__((ext_vector_type(4)));
typedef unsigned u32x4 __attribute__((ext_vector_type(4)));
constexpr int BM = 256, BK = 64, HALF = 128, HTB = HALF * BK * 2  , STAGE_BYTES = 8 * HTB, NXCD = 8, WGM = 8;

__host__ __device__ __forceinline__ int lds_byte(int r, int c) { const int st = (r >> 4) * 2 + (c >> 5), rr = r & 15, cc = c & 31, ob = rr * 64 + cc * 2; return st * 1024 + (ob ^ (((ob >> 9) & 1) << 5)); }
__host__ __device__ __forceinline__ void stage_rc(int b, int& R, int& C) { const int st = b / 1024, sb = b % 1024, swz = sb ^ (((sb >> 9) & 1) << 5); R = (st >> 1) * 16 + swz / 64; C = (st & 1) * 32 + (swz % 64) / 2; }
__host__ __device__ __forceinline__ int perm32(int rho) { const int n = rho >> 4, i = rho & 15; return 8 * (i >> 2) + 4 * n + (i & 3); }

struct Unit { int pm, pn; };
struct Gemm { const bf16_t* A; const bf16_t* Bt; int M, N, K; int a_split; long a_delta; };

struct StaticOrder {
    int nM, nN, nwg, G, c;
    __host__ __device__ void init(int M, int N, int G_, int c_) { nM = M / BM; nN = N / BM; nwg = nM * nN; G = G_; c = c_; }
    __host__ __device__ bool next(int i, Unit& u) const {
        const long L = (long)i * G + c; if (L >= nwg) return false;
        int wgid = (int)L; { const int q = nwg / NXCD, r = nwg % NXCD, xcd = wgid % NXCD, off = wgid / NXCD; wgid = (xcd < r ? xcd * (q + 1) : r * (q + 1) + (xcd - r) * q) + off; }
        const int nig = WGM * nN, gid = wgid / nig, fm = gid * WGM, gsz = (nM - fm) < WGM ? (nM - fm) : WGM;
        u.pm = fm + ((wgid % nig) % gsz); u.pn = (wgid % nig) / gsz; return true;
    }
    __device__ __forceinline__ void a_ready(const Unit&) const {}
    __device__ __forceinline__ void done(const Unit&) const {}
};

__device__ __forceinline__ unsigned cvt_pk_bf16(float lo, float hi) { unsigned r; asm volatile("v_cvt_pk_bf16_f32 %0, %1, %2" : "=v"(r) : "v"(lo), "v"(hi)); return r; }
typedef float f32x2 __attribute__((ext_vector_type(2)));
typedef float f32x2 __attribute__((ext_vector_type(2)));
typedef unsigned u32x2 __attribute__((ext_vector_type(2)));
__device__ __forceinline__ u32x4 pk8(const f32x4 a, const f32x4 b) { u32x4 w; w.x = cvt_pk_bf16(a[0], a[1]); w.y = cvt_pk_bf16(a[2], a[3]); w.z = cvt_pk_bf16(b[0], b[1]); w.w = cvt_pk_bf16(b[2], b[3]); return w; }
__device__ __forceinline__ float bflo(unsigned u) { return __uint_as_float(u << 16); }
__device__ __forceinline__ float bfhi(unsigned u) { return __uint_as_float(u & 0xffff0000u); }
__device__ __forceinline__ float sigmoidf_(float x) { return 1.0f / (1.0f + __expf(-x)); }
__device__ __forceinline__ float rstd16(const float* ss16) { const f32x4 a = *(const f32x4*)ss16, b = *(const f32x4*)(ss16 + 4), c = *(const f32x4*)(ss16 + 8), d = *(const f32x4*)(ss16 + 12);
    const float s = ((a[0] + a[1]) + (a[2] + a[3])) + ((b[0] + b[1]) + (b[2] + b[3])) + ((c[0] + c[1]) + (c[2] + c[3])) + ((d[0] + d[1]) + (d[2] + d[3])); return 1.0f / sqrtf(s * (1.0f / 1024.0f) + 1e-6f); }

struct EpiP1 {
    static constexpr bool PERM = true, AFTER_DRAIN = false;
    bf16_t *d0, *d1, *d2, *d3, *d4, *d5; const float* rstd; const float* rcos; const float* rsin; float qscale; bf16_t* halo;
    __device__ __forceinline__ void operator()(const f32x4 (&acc)[2][2][4][2], const Unit& u, int wr, int wc, int fr, int fq) const {
        const int grp = u.pn >> 2; bf16_t* base = grp == 0 ? d0 : grp == 1 ? d1 : grp == 2 ? d2 : grp == 3 ? d3 : grp == 4 ? d4 : d5; const int col0 = (u.pn & 3) * BM + wc * 32 + 8 * fq;
        const bool rope = (grp == 3 || grp == 4) && ((wc & 1) == 0); const float sc = (grp == 3) ? qscale : 1.0f;
#pragma unroll
        for (int ai = 0; ai < 2; ++ai)
#pragma unroll
            for (int m = 0; m < 4; ++m) { const int row = u.pm * BM + ai * HALF + wr * 64 + m * 16 + fr; const float rs = rstd[row] * sc;
                f32x4 c0 = {1.f, 1.f, 1.f, 1.f}, c1 = c0, s0 = {0.f, 0.f, 0.f, 0.f}, s1 = s0;
                if (rope) { c0 = *(const f32x4*)(rcos + (size_t)row * 8); c1 = *(const f32x4*)(rcos + (size_t)row * 8 + 4); s0 = *(const f32x4*)(rsin + (size_t)row * 8); s1 = *(const f32x4*)(rsin + (size_t)row * 8 + 4);
                    if (fq >= 2) { c0 = (f32x4){1.f, 1.f, 1.f, 1.f}; c1 = c0; s0 = (f32x4){0.f, 0.f, 0.f, 0.f}; s1 = s0; } else if (fq == 0) { s0 = -s0; s1 = -s1; } }
#pragma unroll
                for (int bj = 0; bj < 2; ++bj) { f32x4 v0 = acc[ai][bj][m][0] * rs, v1 = acc[ai][bj][m][1] * rs;
                    if (rope) { f32x4 p0, p1;
#pragma unroll
                        for (int e = 0; e < 4; ++e) { p0[e] = __shfl_xor(v0[e], 16); p1[e] = __shfl_xor(v1[e], 16); }
                        v0 = v0 * c0 + p0 * s0; v1 = v1 * c1 + p1 * s1; }
                    const u32x4 pw = pk8(v0, v1); *(u32x4*)(base + (size_t)row * 1024 + col0 + bj * HALF) = pw;
                    if (m == 3 && grp < 3 && fr >= 13) *(u32x4*)(halo + ((size_t)(row >> 6) * 3 + (fr - 13)) * 3072 + grp * 1024 + col0 + bj * HALF) = pw; } }
    }
};
struct EpiP3a {
    static constexpr bool PERM = true, AFTER_DRAIN = false;
    bf16_t* gates; bf16_t* oa; const float* rstd;
    __device__ __forceinline__ void operator()(const f32x4 (&acc)[2][2][4][2], const Unit& u, int wr, int wc, int fr, int fq) const {
        const bool isg = u.pn < 8; const int col0 = (isg ? u.pn * BM : (u.pn - 8) * BM) + wc * 32 + 8 * fq;
#pragma unroll
        for (int ai = 0; ai < 2; ++ai)
#pragma unroll
            for (int m = 0; m < 4; ++m) { const int row = u.pm * BM + ai * HALF + wr * 64 + m * 16 + fr; const float rs = rstd[row];
#pragma unroll
                for (int bj = 0; bj < 2; ++bj) { f32x4 v0 = acc[ai][bj][m][0] * rs, v1 = acc[ai][bj][m][1] * rs;
#pragma unroll
                    for (int e = 0; e < 4; ++e) { v0[e] = sigmoidf_(v0[e]); v1[e] = sigmoidf_(v1[e]); }
                    if (isg) { *(u32x4*)(gates + (size_t)row * 2048 + col0 + bj * HALF) = pk8(v0, v1); }
                    else { u32x4* p = (u32x4*)(oa + (size_t)row * 1024 + col0 + bj * HALF); const u32x4 o = *p; const f32x4 z0 = acc[ai][bj][m][0] * rs, z1 = acc[ai][bj][m][1] * rs;
                        f32x4 a0 = {bflo(o.x), bfhi(o.x), bflo(o.y), bfhi(o.y)}, a1 = {bflo(o.z), bfhi(o.z), bflo(o.w), bfhi(o.w)};
                        a0 = a0 * (z0 * v0); a1 = a1 * (z1 * v1); *p = pk8(a0, a1); } } }
    }
};
struct EpiP3b {
    static constexpr bool PERM = true, AFTER_DRAIN = false;
    const bf16_t* gates; bf16_t* merged;
    __device__ __forceinline__ void operator()(const f32x4 (&acc)[2][2][4][2], const Unit& u, int wr, int wc, int fr, int fq) const {
        const bool second = u.pn >= 4; const int col0 = (u.pn & 3) * BM + wc * 32 + 8 * fq;
#pragma unroll
        for (int ai = 0; ai < 2; ++ai)
#pragma unroll
            for (int m = 0; m < 4; ++m) { const int row = u.pm * BM + ai * HALF + wr * 64 + m * 16 + fr;
#pragma unroll
                for (int bj = 0; bj < 2; ++bj) { const u32x4 g = *(const u32x4*)(gates + (size_t)row * 2048 + (second ? 1024 : 0) + col0 + bj * HALF);
                    const f32x4 g0 = {bflo(g.x), bfhi(g.x), bflo(g.y), bfhi(g.y)}, g1 = {bflo(g.z), bfhi(g.z), bflo(g.w), bfhi(g.w)};
                    f32x4 v0 = acc[ai][bj][m][0] * g0, v1 = acc[ai][bj][m][1] * g1; u32x4* p = (u32x4*)(merged + (size_t)row * 1024 + col0 + bj * HALF);
                    if (second) { const u32x4 t = *p; v0 = v0 + (f32x4){bflo(t.x), bfhi(t.x), bflo(t.y), bfhi(t.y)}; v1 = v1 + (f32x4){bflo(t.z), bfhi(t.z), bflo(t.w), bfhi(t.w)}; }
                    *p = pk8(v0, v1); } }
    }
};
struct EpiRes {
    static constexpr bool PERM = false, AFTER_DRAIN = false;
    const float* res; float* xo; bf16_t* xb; float* ss;
    __device__ __forceinline__ void operator()(const f32x4 (&acc)[2][2][4][2], const Unit& u, int wr, int wc, int fr, int fq) const {
        const int col0 = u.pn * BM + wc * 32 + 4 * fq;
#pragma unroll
        for (int ai = 0; ai < 2; ++ai)
#pragma unroll
            for (int m = 0; m < 4; ++m) { const int row = u.pm * BM + ai * HALF + wr * 64 + m * 16 + fr; const size_t off = (size_t)row * 1024 + col0; float s = 0.f;
#pragma unroll
                for (int bj = 0; bj < 2; ++bj)
#pragma unroll
                    for (int n = 0; n < 2; ++n) { const size_t o = off + bj * HALF + n * 16; const f32x4 v = *(const f32x4*)(res + o) + acc[ai][bj][m][n]; *(f32x4*)(xo + o) = v;
                        s += (v[0] * v[0] + v[1] * v[1]) + (v[2] * v[2] + v[3] * v[3]);
                        if (xb) { u32x2 w; w.x = cvt_pk_bf16(v[0], v[1]); w.y = cvt_pk_bf16(v[2], v[3]); *(u32x2*)(xb + o) = w; } }
                s += __shfl_xor(s, 16); s += __shfl_xor(s, 32);
                if (fq == 0) ss[(size_t)row * 16 + u.pn * 4 + wc] = s;
                if (m & 1) asm volatile("" ::: "memory"); }
    }
};
struct EpiRowBf16 {
    static constexpr bool PERM = true, AFTER_DRAIN = false;
    bf16_t* out; int ldc; const float* rs1; const float* ss16;
    __device__ __forceinline__ void operator()(const f32x4 (&acc)[2][2][4][2], const Unit& u, int wr, int wc, int fr, int fq) const {
        const int col0 = u.pn * BM + wc * 32 + 8 * fq;
#pragma unroll
        for (int ai = 0; ai < 2; ++ai)
#pragma unroll
            for (int m = 0; m < 4; ++m) { const int row = u.pm * BM + ai * HALF + wr * 64 + m * 16 + fr; const float rs = ss16 ? rstd16(ss16 + (size_t)row * 16) : rs1[row];
#pragma unroll
                for (int bj = 0; bj < 2; ++bj) *(u32x4*)(out + (size_t)row * ldc + col0 + bj * HALF) = pk8(acc[ai][bj][m][0] * rs, acc[ai][bj][m][1] * rs); }
    }
};
struct EpiAct {
    static constexpr bool PERM = true, AFTER_DRAIN = false;
    bf16_t* act; const float* ss16;
    __device__ __forceinline__ void operator()(const f32x4 (&acc)[2][2][4][2], const Unit& u, int wr, int wc, int fr, int fq) const {
        const int col0 = u.pn * HALF + wc * 32 + 8 * fq;
#pragma unroll
        for (int ai = 0; ai < 2; ++ai)
#pragma unroll
            for (int m = 0; m < 4; ++m) { const int row = u.pm * BM + ai * HALF + wr * 64 + m * 16 + fr; const float rs = rstd16(ss16 + (size_t)row * 16);
                f32x4 a[2];
#pragma unroll
                for (int n = 0; n < 2; ++n) { const f32x4 g = acc[ai][0][m][n] * rs, up = acc[ai][1][m][n] * rs;
#pragma unroll
                    for (int e = 0; e < 4; ++e) a[n][e] = g[e] * sigmoidf_(g[e]) * up[e]; }
                *(u32x4*)(act + (size_t)row * 2816 + col0) = pk8(a[0], a[1]); }
    }
};
struct PairOrder {
    StaticOrder so;
    __device__ void init(int M, int G_, int c_) { so.init(M, 1024, G_, c_); }
    __device__ bool next(int i, Unit& u) const { if (!so.next(i >> 1, u)) return false; u.pn += 4 * (i & 1); return true; }
    __device__ __forceinline__ void a_ready(const Unit&) const {}
    __device__ __forceinline__ void done(const Unit&) const {}
};
template <class Epi, class Sched, bool ALIGN_EPI = false, bool SP2 = false>
__device__ __forceinline__ void gemm_phase(PG8_LAS unsigned char* lds, const Gemm g, const Sched& S, const Epi& E, const int wid) {
    const int lane = lane_id(), tid = wid * 64 + lane, wr = wid >> 2, wc = wid & 3, fr = lane & 15, fq = lane >> 4;
    const int K = g.K, nt = K / BK;
    unsigned voffA[2], voffB[2];
#pragma unroll
    for (int i = 0; i < 2; ++i) { int R, C; stage_rc(tid * 16 + i * 8192, R, C); const int Rb = Epi::PERM ? ((R & ~31) + perm32(R & 31)) : R;
        voffA[i] = (unsigned)(R * K + C) * 2u; voffB[i] = (unsigned)(Rb * K + C) * 2u; }
    const size_t kstep = (size_t)(BK * 2);
    const size_t hstep = (size_t)HALF * K * 2;
    const size_t tstep = 2 * hstep;
    const unsigned ldsw = (unsigned)wid * 1024u;
    const int aoff = lds_byte(wr * 64 + fr, fq * 8), boff = lds_byte(wc * 32 + fr, fq * 8);
#define PG8_SA(b, h) (((b) * 2 + (h)) * HTB)
#define PG8_SB(b, h) ((4 + (b) * 2 + (h)) * HTB)
#define PG8_STAGE(bufoff, gbase, voff) do { _Pragma("unroll") for (int _i = 0; _i < 2; ++_i) \
        __builtin_amdgcn_global_load_lds((const unsigned*)((const char*)(gbase) + (voff)[_i]), (PG8_LAS unsigned*)(lds + (bufoff) + ldsw + _i * 8192), 16, 0, 0); } while (0)
#define PG8_LDA(dst, b, h) do { _Pragma("unroll") for (int m = 0; m < 4; ++m) _Pragma("unroll") for (int k = 0; k < 2; ++k) dst[m][k] = *(const PG8_LAS bf16x8*)(lds + PG8_SA(b, h) + aoff + m * 2048 + k * 1024); } while (0)
#define PG8_LDB(dst, b, h) do { _Pragma("unroll") for (int n = 0; n < 2; ++n) _Pragma("unroll") for (int k = 0; k < 2; ++k) dst[n][k] = *(const PG8_LAS bf16x8*)(lds + PG8_SB(b, h) + boff + n * 2048 + k * 1024); } while (0)
#define PG8_MMA(ai, bj, At, Bt) do { __builtin_amdgcn_s_setprio(1); _Pragma("unroll") for (int m = 0; m < 4; ++m) _Pragma("unroll") for (int n = 0; n < 2; ++n) _Pragma("unroll") for (int k = 0; k < 2; ++k) \
        acc[ai][bj][m][n] = __builtin_amdgcn_mfma_f32_16x16x32_bf16(Bt[n][k], At[m][k], acc[ai][bj][m][n], 0, 0, 0); __builtin_amdgcn_s_setprio(0); } while (0)
#define PG8_WAIT_V(n) asm volatile("s_waitcnt vmcnt(" #n ")" ::: "memory")
#define PG8_WAIT_L(n) asm volatile("s_waitcnt lgkmcnt(" #n ")" ::: "memory")
#define PG8_BAR __builtin_amdgcn_s_barrier()
#define PG8_SCHED __builtin_amdgcn_sched_barrier(0)
    Unit cur, nxt; int ui = 0;
    if (!S.next(0, cur)) return;
    f32x4 acc[2][2][4][2];
#pragma unroll
    for (int a = 0; a < 2; ++a)
#pragma unroll
        for (int b = 0; b < 2; ++b)
#pragma unroll
            for (int m = 0; m < 4; ++m)
#pragma unroll
                for (int n = 0; n < 2; ++n) acc[a][b][m][n] = (f32x4){0.f, 0.f, 0.f, 0.f};
    bf16x8 At[4][2], B0[2][2], B1[2][2];
    const char* cA = (const char*)g.A + (size_t)cur.pm * tstep + (cur.pn >= g.a_split ? g.a_delta : 0L); const char* cB = (const char*)g.Bt + (size_t)cur.pn * tstep;
    S.a_ready(cur);
    if constexpr (SP2) {
        PG8_STAGE(PG8_SB(0, 0), cB, voffB); PG8_STAGE(PG8_SB(0, 1), cB + hstep, voffB); PG8_STAGE(PG8_SA(0, 0), cA, voffA); PG8_STAGE(PG8_SA(0, 1), cA + hstep, voffA);
        if (wr == 1) PG8_BAR;
        PG8_WAIT_V(2); PG8_BAR;
        PG8_STAGE(PG8_SB(1, 0), cB + kstep, voffB); PG8_STAGE(PG8_SA(1, 0), cA + kstep, voffA); PG8_STAGE(PG8_SB(1, 1), cB + hstep + kstep, voffB);
        PG8_WAIT_V(6); PG8_BAR;
    } else {
        PG8_STAGE(PG8_SB(0, 0), cB, voffB); PG8_STAGE(PG8_SA(0, 0), cA, voffA); PG8_STAGE(PG8_SB(0, 1), cB + hstep, voffB); PG8_STAGE(PG8_SA(0, 1), cA + hstep, voffA);
        if (wr == 1) PG8_BAR;
        PG8_WAIT_V(4); PG8_BAR;
        PG8_STAGE(PG8_SB(1, 0), cB + kstep, voffB); PG8_STAGE(PG8_SA(1, 0), cA + kstep, voffA); PG8_STAGE(PG8_SB(1, 1), cB + hstep + kstep, voffB);
        PG8_WAIT_V(6); PG8_BAR;
    }
    for (;;) {
        const bool has_next = S.next(ui + 1, nxt);
        const char* nA = has_next ? (const char*)g.A + (size_t)nxt.pm * tstep + (nxt.pn >= g.a_split ? g.a_delta : 0L) : cA; const char* nB = has_next ? (const char*)g.Bt + (size_t)nxt.pn * tstep : cB;
        for (int t = 0; t < nt; t += 2) {
            const bool last = (t == nt - 2);
            const char* a1 = cA + (size_t)(t + 1) * kstep;
            const char* a2 = last ? nA : cA + (size_t)(t + 2) * kstep; const char* b2 = last ? nB : cB + (size_t)(t + 2) * kstep;
            const char* a3 = a2 + kstep; const char* b3 = b2 + kstep;
            if (last && has_next) S.a_ready(nxt);
            if constexpr (SP2) {
            PG8_LDB(B0, 0, 0); PG8_LDB(B1, 0, 1); PG8_SCHED; PG8_LDA(At, 0, 0); PG8_STAGE(PG8_SA(1, 1), a1 + hstep, voffA);
            PG8_WAIT_V(8); PG8_WAIT_L(0); PG8_BAR; PG8_MMA(0, 0, At, B0); PG8_MMA(0, 1, At, B1); PG8_BAR; PG8_SCHED;
            PG8_LDA(At, 0, 1); PG8_STAGE(PG8_SB(0, 0), b2, voffB); PG8_STAGE(PG8_SB(0, 1), b2 + hstep, voffB); PG8_STAGE(PG8_SA(0, 0), a2, voffA);
            PG8_WAIT_V(8); PG8_WAIT_L(0); PG8_BAR; PG8_MMA(1, 0, At, B0); PG8_MMA(1, 1, At, B1); PG8_BAR; PG8_SCHED;
            PG8_LDB(B0, 1, 0); PG8_LDB(B1, 1, 1); PG8_SCHED; PG8_LDA(At, 1, 0); PG8_STAGE(PG8_SA(0, 1), a2 + hstep, voffA);
            PG8_WAIT_V(8); PG8_WAIT_L(0); PG8_BAR; PG8_MMA(0, 0, At, B0); PG8_MMA(0, 1, At, B1); PG8_BAR; PG8_SCHED;
            PG8_LDA(At, 1, 1); PG8_STAGE(PG8_SB(1, 0), b3, voffB); PG8_STAGE(PG8_SB(1, 1), b3 + hstep, voffB); PG8_STAGE(PG8_SA(1, 0), a3, voffA);
            PG8_WAIT_V(8); PG8_WAIT_L(0); PG8_BAR; PG8_MMA(1, 0, At, B0); PG8_MMA(1, 1, At, B1); PG8_BAR; PG8_SCHED;
            } else {
            PG8_LDB(B0, 0, 0); PG8_SCHED; PG8_LDA(At, 0, 0); PG8_STAGE(PG8_SA(1, 1), a1 + hstep, voffA);
            PG8_WAIT_L(8); PG8_BAR; PG8_WAIT_L(0); PG8_MMA(0, 0, At, B0); PG8_BAR; PG8_SCHED;
            PG8_LDB(B1, 0, 1); PG8_STAGE(PG8_SB(0, 0), b2, voffB);
            PG8_BAR; PG8_WAIT_L(0); PG8_MMA(0, 1, At, B1); PG8_BAR;
            PG8_LDA(At, 0, 1); PG8_STAGE(PG8_SA(0, 0), a2, voffA);
            PG8_BAR; PG8_WAIT_L(0); PG8_MMA(1, 0, At, B0); PG8_BAR; PG8_SCHED;
            PG8_STAGE(PG8_SB(0, 1), b2 + hstep, voffB);
            PG8_WAIT_V(6); PG8_BAR; PG8_MMA(1, 1, At, B1); PG8_BAR;
            PG8_LDB(B0, 1, 0); PG8_SCHED; PG8_LDA(At, 1, 0); PG8_STAGE(PG8_SA(0, 1), a2 + hstep, voffA);
            PG8_WAIT_L(8); PG8_BAR; PG8_WAIT_L(0); PG8_MMA(0, 0, At, B0); PG8_BAR; PG8_SCHED;
            PG8_LDB(B1, 1, 1); PG8_STAGE(PG8_SB(1, 0), b3, voffB);
            PG8_BAR; PG8_WAIT_L(0); PG8_MMA(0, 1, At, B1); PG8_BAR;
            PG8_LDA(At, 1, 1); PG8_STAGE(PG8_SA(1, 0), a3, voffA);
            PG8_BAR; PG8_WAIT_L(0); PG8_MMA(1, 0, At, B0); PG8_BAR; PG8_SCHED;
            PG8_STAGE(PG8_SB(1, 1), b3 + hstep, voffB);
            PG8_WAIT_V(6); PG8_BAR; PG8_MMA(1, 1, At, B1); PG8_BAR;
            }
        }
        if constexpr (ALIGN_EPI) { if (wr == 0) PG8_BAR; }
        if constexpr (!Epi::AFTER_DRAIN) { E(acc, cur, wr, wc, fr, fq); S.done(cur); }
        if (!has_next) break;
#pragma unroll
        for (int a = 0; a < 2; ++a)
#pragma unroll
            for (int b = 0; b < 2; ++b)
#pragma unroll
                for (int m = 0; m < 4; ++m)
#pragma unroll
                    for (int n = 0; n < 2; ++n) acc[a][b][m][n] = (f32x4){0.f, 0.f, 0.f, 0.f};
        cur = nxt; cA = nA; cB = nB; ++ui;
        if constexpr (ALIGN_EPI) { if (wr == 1) PG8_BAR; }
    }
    PG8_WAIT_V(0);
    if constexpr (!ALIGN_EPI) { if (wr == 0) PG8_BAR; }
    PG8_BAR;
    if constexpr (Epi::AFTER_DRAIN) { E.fused(acc, cur, wr, wc, fr, fq, lds, wid, lane); S.done(cur); }
#undef PG8_SA
#undef PG8_SB
#undef PG8_STAGE
#undef PG8_LDA
#undef PG8_LDB
#undef PG8_MMA
#undef PG8_WAIT_V
#undef PG8_WAIT_L
#undef PG8_BAR
#undef PG8_SCHED
}
}
#include <hip/hip_bf16.h>
#include <cmath>
namespace attn_body {
using bf16=__hip_bfloat16;
using bf16x8=__attribute__((ext_vector_type(8)))short;
using s16x4=__attribute__((ext_vector_type(4)))short;
using f32x16=__attribute__((ext_vector_type(16)))float;
using u32x4=__attribute__((ext_vector_type(4)))unsigned;
constexpr int BATCH=4,NHEAD=16,SEQ=4096,D=64,DM=1024;
constexpr int NW=8,QBLK=32,QB=QBLK*NW,KVBLK=64,NQB=SEQ/QB;
constexpr int ATTN_PITCH=DM, ATTN_UNIT_ROWS=QB;
__device__ __forceinline__ int crow(int r,int hi){return (r&3)+8*(r>>2)+4*hi;}
#define SBAR() __builtin_amdgcn_sched_barrier(0)
__device__ __forceinline__ void cmask(f32x16&p0,f32x16&p1,int jb,int qrel,int hi){
  const float NEG=-INFINITY; int kb=64*jb+4*hi;
  #pragma unroll
  for(int r=0;r<16;++r){int kv=kb+(r&3)+8*(r>>2); if(kv>qrel)p0[r]=NEG; if(kv+32>qrel)p1[r]=NEG;}
}

constexpr int NSLOT=3, SLOTB=8192;
constexpr int LDS_K=0, LDS_V=NSLOT*SLOTB, LDS_WS=2*NSLOT*SLOTB, LDS_OST=LDS_WS+NW*64*4, LDS_STA=LDS_OST+NW*4096, LDS_STC=LDS_STA+NW*4096, LDS_BYTES=LDS_STC+NW*4096;
constexpr float C2=0.125f*1.4426950408889634f;
__device__ __forceinline__ void glds16(const void*gsrc,unsigned lds_dst){unsigned keep;
  asm volatile("s_mov_b32 %0, m0\n\ts_mov_b32 m0, %2\n\ts_nop 0\n\tglobal_load_lds_dwordx4 %1, off\n\ts_mov_b32 m0, %0":"=&s"(keep):"v"(gsrc),"s"(lds_dst):"memory");}
__device__ __forceinline__ float max3f(float a,float b,float c){float r;asm("v_max3_f32 %0, %1, %2, %3":"=v"(r):"v"(a),"v"(b),"v"(c));return r;}
__device__ __forceinline__ float max2f(float a,float b){float r;asm("v_max_f32_e32 %0, %1, %2":"=v"(r):"v"(a),"v"(b));return r;}
__device__ __forceinline__ float fadd_s(float a,float b){float r;asm("v_add_f32_e32 %0, %1, %2":"=v"(r):"v"(a),"v"(b));return r;}
__device__ __forceinline__ float fsub_s(float a,float b){float r;asm("v_sub_f32_e32 %0, %1, %2":"=v"(r):"v"(a),"v"(b));return r;}
typedef float f32x2_t __attribute__((ext_vector_type(2))); typedef __bf16 bf16x2_t __attribute__((ext_vector_type(2)));
__device__ __forceinline__ unsigned cvtpk_s(float lo,float hi){f32x2_t v={lo,hi};bf16x2_t b=__builtin_convertvector(v,bf16x2_t);return __builtin_bit_cast(unsigned,b);}
#define WAIT_BAR(N) asm volatile("s_waitcnt vmcnt(" #N ") lgkmcnt(0)\n\ts_barrier":::"memory")

__device__ __forceinline__ void qkt(f32x16&p0,f32x16&p1,const char*Kslot,const bf16x8*qr,const f32x16&negm,int r32,int hi){
  const char*kb=Kslot+hi*1024+r32*16;
  #pragma unroll
  for(int d0=0;d0<4;++d0){
    const bf16x8 b0=*reinterpret_cast<const bf16x8*>(kb+d0*2048);
    const bf16x8 b1=*reinterpret_cast<const bf16x8*>(kb+d0*2048+512);
    if(d0==0){p0=__builtin_amdgcn_mfma_f32_32x32x16_bf16(b0,qr[0],negm,0,0,0);p1=__builtin_amdgcn_mfma_f32_32x32x16_bf16(b1,qr[0],negm,0,0,0);}
    else{p0=__builtin_amdgcn_mfma_f32_32x32x16_bf16(b0,qr[d0],p0,0,0,0);p1=__builtin_amdgcn_mfma_f32_32x32x16_bf16(b1,qr[d0],p1,0,0,0);}}
}
typedef __attribute__((address_space(3))) const char* lds_cptr;
typedef short v4i16_t __attribute__((ext_vector_type(4)));
__device__ __forceinline__ void kload8(bf16x8*kf,lds_cptr kp){
  kf[0]=*(const __attribute__((address_space(3))) bf16x8*)(kp);      kf[1]=*(const __attribute__((address_space(3))) bf16x8*)(kp+512);
  kf[2]=*(const __attribute__((address_space(3))) bf16x8*)(kp+2048); kf[3]=*(const __attribute__((address_space(3))) bf16x8*)(kp+2560);
  kf[4]=*(const __attribute__((address_space(3))) bf16x8*)(kp+4096); kf[5]=*(const __attribute__((address_space(3))) bf16x8*)(kp+4608);
  kf[6]=*(const __attribute__((address_space(3))) bf16x8*)(kp+6144); kf[7]=*(const __attribute__((address_space(3))) bf16x8*)(kp+6656);
}
__device__ __forceinline__ void kload2(bf16x8*kf,lds_cptr kp,int j){ kf[2*j]=*(const __attribute__((address_space(3))) bf16x8*)(kp+j*2048); kf[2*j+1]=*(const __attribute__((address_space(3))) bf16x8*)(kp+j*2048+512); }
__device__ __forceinline__ s16x4 vtr(lds_cptr p){ return __builtin_bit_cast(s16x4,__builtin_amdgcn_ds_read_tr16_b64_v4i16((__attribute__((address_space(3))) v4i16_t*)p)); }
__device__ __forceinline__ float rowmax(const f32x16&p0,const f32x16&p1){
  float a=max3f(p0[0],p0[1],p1[0]),b=max3f(p0[2],p0[3],p1[1]);a=max3f(a,p1[2],p1[3]);
  #pragma unroll
  for(int r=4;r<16;r+=4){a=max3f(a,p0[r],p0[r+1]);b=max3f(b,p0[r+2],p0[r+3]);a=max3f(a,p1[r],p1[r+1]);b=max3f(b,p1[r+2],p1[r+3]);}
  const float m=max2f(a,b);
  auto rr=__builtin_amdgcn_permlane32_swap(__float_as_uint(m),__float_as_uint(m),false,false);
  return max2f(__uint_as_float(rr[0]),__uint_as_float(rr[1]));
}
__device__ __forceinline__ void pv(f32x16*o,int vb,bf16x8 pa0,bf16x8 pa1,bf16x8 pa2,bf16x8 pa3){
  #pragma unroll
  for(int d0=0;d0<2;++d0){s16x4 lo[4],hi[4];
    #pragma unroll
    for(int ks=0;ks<4;++ks){
      asm volatile("ds_read_b64_tr_b16 %0,%1 offset:%c2":"=&v"(lo[ks]):"v"(vb),"i"(d0*4096+ks*1024):"memory");
      asm volatile("ds_read_b64_tr_b16 %0,%1 offset:%c2":"=&v"(hi[ks]):"v"(vb),"i"(d0*4096+ks*1024+512):"memory");}
    asm volatile("s_waitcnt lgkmcnt(0)":::"memory");SBAR();
    #define PK(k) (bf16x8){lo[k][0],lo[k][1],lo[k][2],lo[k][3],hi[k][0],hi[k][1],hi[k][2],hi[k][3]}
    o[d0]=__builtin_amdgcn_mfma_f32_32x32x16_bf16(pa0,PK(0),o[d0],0,0,0);
    o[d0]=__builtin_amdgcn_mfma_f32_32x32x16_bf16(pa1,PK(1),o[d0],0,0,0);
    o[d0]=__builtin_amdgcn_mfma_f32_32x32x16_bf16(pa2,PK(2),o[d0],0,0,0);
    o[d0]=__builtin_amdgcn_mfma_f32_32x32x16_bf16(pa3,PK(3),o[d0],0,0,0);
    #undef PK
  }
}

#ifndef ATTN_STORE16
#define ATTN_STORE16(p,v) (*(u32x4*)(p)=(v))
#endif
template<int THRL> __device__ __forceinline__ void attn_unit(int b,int qcol,int vcol,int ocol,int qb,int mode,float lam,const bf16*Q,const bf16*K,const bf16*V,bf16*O,char*shm,const int wid){
  const int lane=lane_id(),r32=lane&31,hi=lane>>5;
  const long rowbase=(long)b*SEQ; const int q0=qb*QB;
  const bf16*Qw=Q+(rowbase+q0+wid*QBLK)*DM+qcol;
  const bf16*Kh=K+rowbase*DM+qcol,*Vh=V+rowbase*DM+vcol;
  const unsigned lds0=(unsigned)(uintptr_t)shm;
  float*wsf=(float*)(shm+LDS_WS)+wid*64;
  const bf16*ksrc=Kh+(long)lane*DM+wid*8;
  const bf16*vsrc=Vh+(long)(16*(wid&3)+(lane>>2))*DM+(wid>>2)*32+(lane&3)*8;
  const unsigned kdst=lds0+LDS_K+wid*1024, vdst=lds0+LDS_V+wid*1024;
  #define DMA_K(t,slot) glds16(ksrc+(long)(t)*KVBLK*DM,(unsigned)__builtin_amdgcn_readfirstlane(kdst+(slot)))
  #define DMA_V(t,slot) glds16(vsrc+(long)(t)*KVBLK*DM,(unsigned)__builtin_amdgcn_readfirstlane(vdst+(slot)))
  const int vb0=(int)(lds0+LDS_V)+((lane>>4)&1)*32+(lane&3)*8+(4*hi+((lane&15)>>2))*64;
  const char*Kbase=shm+LDS_K; bf16x8 kf[8];
  const lds_cptr shm3=(lds_cptr)shm; const lds_cptr kp0=shm3+LDS_K+hi*1024+r32*16; const lds_cptr vp0=shm3+LDS_V+((lane>>4)&1)*32+(lane&3)*8+(4*hi+((lane&15)>>2))*64;
  const int NT=(q0+QB)/KVBLK;
  DMA_K(0,0);DMA_V(0,0);DMA_K(1,SLOTB);
  bf16x8 qr[4];
  #pragma unroll
  for(int d0=0;d0<4;++d0)qr[d0]=*reinterpret_cast<const bf16x8*>(&Qw[(long)r32*DM+d0*16+hi*8]);
  float mhat=0.f,l_reg=0.f;f32x16 o[2];o[0]=f32x16{};o[1]=f32x16{};f32x16 negm=f32x16{};asm volatile("":"+v"(negm));
  const int qrel=wid*QBLK+r32;
  #define CMASK(P0,P1,t) do{int jb_=(t)-(NT-4); if(jb_>=0)cmask(P0,P1,jb_,qrel,hi);}while(0)
  bool resc=false;
  #define START(P0,P1) do{ const float rm=rowmax(P0,P1); resc=false; \
    { const float dl=rm; mhat=fadd_s(mhat,dl); \
      _Pragma("unroll") for(int r=0;r<16;++r){P0[r]=fsub_s(P0[r],dl);P1[r]=fsub_s(P1[r],dl);} \
      _Pragma("unroll") for(int r=0;r<16;++r)negm[r]=-mhat; asm volatile("":"+v"(negm)); } \
    _Pragma("unroll") for(int r=0;r<16;++r)P0[r]=__builtin_amdgcn_exp2f(P0[r]); }while(0)
  #define RESC() do{ if(resc){ asm volatile("s_waitcnt lgkmcnt(0)":::"memory"); \
      _Pragma("unroll") for(int d_=0;d_<2;++d_) _Pragma("unroll") for(int r=0;r<16;++r)o[d_][r]*=wsf[crow(r,hi)]; } }while(0)
  f32x16 pA0,pA1,pB0,pB1;
  int sl_prev=0,sl_cur=0,sl_next=SLOTB;
  #define ROT() do{sl_prev=sl_cur;sl_cur=sl_next;sl_next=(sl_next==(NSLOT-1)*SLOTB)?0:sl_next+SLOTB;}while(0)
  DMA_K(2,2*SLOTB);
  WAIT_BAR(3);
  qkt(pA0,pA1,Kbase,qr,negm,r32,hi);asm volatile("s_nop 15\n\ts_nop 7":"+v"(pA0),"+v"(pA1));CMASK(pA0,pA1,0);
  START(pA0,pA1);
  _Pragma("unroll") for(int r=0;r<16;++r)pA1[r]=__builtin_amdgcn_exp2f(pA1[r]);
  WAIT_BAR(0);
  DMA_K(3,0);DMA_V(1,SLOTB);
  ROT();
  kload8(kf,kp0+sl_cur);
  WAIT_BAR(2);
  s16x4 vlo[8],vhi[8]; u32x4 pw0,pw1,pw2,pw3;
  #define PKW(P,B) cvtpk_s(P[B],P[B+1])
  #define PAF(k) __builtin_bit_cast(bf16x8,pw##k)
  #define VFR(i) (bf16x8){vlo[i][0],vlo[i][1],vlo[i][2],vlo[i][3],vhi[i][0],vhi[i][1],vhi[i][2],vhi[i][3]}
  #define PIN(x) asm volatile("":"+v"(x))
  #define MX3(a,b,c) __builtin_fmaxf(__builtin_fmaxf((a),(b)),(c))
  #define GAPA(MF,A0,A1,A2,A3,W0,W1,PW) do{ MF; sacc+=A0; sacc+=A1; sacc+=A2; sacc+=A3; PIN(sacc); W0; W1; PIN(PW); SBAR(); }while(0)
  #define EX(v) __builtin_amdgcn_exp2f(v)
  #define GAPB(MF,X,B) do{ MF; X[B]=EX(X[B]); X[B+1]=EX(X[B+1]); X[B+2]=EX(X[B+2]); X[B+3]=EX(X[B+3]); PIN(X); SBAR(); }while(0)
  #define VRD(i) do{ vlo[i]=vtr(vp_+(((i)>>2)*4096+((i)&3)*1024)); vhi[i]=vtr(vp_+(((i)>>2)*4096+((i)&3)*1024+512)); }while(0)
  #define KRD(G,j) do{ if(G){ kload2(kf,kp0+sl_next,j); SBAR(); } }while(0)
  #define STEP(C0,C1,P0,P1,t,GK,GV,GL) do{ SBAR(); \
    const lds_cptr vp_=vp0+sl_prev; \
    VRD(0); SBAR(); float sacc=(P0[0]+P0[1]); \
    GAPA(C0=__builtin_amdgcn_mfma_f32_32x32x16_bf16(kf[0],qr[0],negm,0,0,0), P0[2],P0[3],P0[4],P0[5],     pw0[0]=PKW(P0,0), pw0[1]=PKW(P0,2), pw0); \
    VRD(4); SBAR(); GAPA(C1=__builtin_amdgcn_mfma_f32_32x32x16_bf16(kf[1],qr[0],negm,0,0,0), P0[6],P0[7],P0[8],P0[9],     pw0[2]=PKW(P0,4), pw0[3]=PKW(P0,6), pw0); \
    VRD(1); SBAR(); GAPA(C0=__builtin_amdgcn_mfma_f32_32x32x16_bf16(kf[2],qr[1],C0,0,0,0),   P0[10],P0[11],P0[12],P0[13], pw1[0]=PKW(P0,8), pw1[1]=PKW(P0,10), pw1); \
    VRD(5); SBAR(); GAPA(C1=__builtin_amdgcn_mfma_f32_32x32x16_bf16(kf[3],qr[1],C1,0,0,0),   P0[14],P0[15],P1[0],P1[1],   pw1[2]=PKW(P0,12),pw1[3]=PKW(P0,14), pw1); \
    VRD(2); SBAR(); GAPA(C0=__builtin_amdgcn_mfma_f32_32x32x16_bf16(kf[4],qr[2],C0,0,0,0),   P1[2],P1[3],P1[4],P1[5],     pw2[0]=PKW(P1,0), pw2[1]=PKW(P1,2), pw2); \
    VRD(6); SBAR(); GAPA(C1=__builtin_amdgcn_mfma_f32_32x32x16_bf16(kf[5],qr[2],C1,0,0,0),   P1[6],P1[7],P1[8],P1[9],     pw2[2]=PKW(P1,4), pw2[3]=PKW(P1,6), pw2); \
    VRD(3); SBAR(); GAPA(C0=__builtin_amdgcn_mfma_f32_32x32x16_bf16(kf[6],qr[3],C0,0,0,0),   P1[10],P1[11],P1[12],P1[13], pw3[0]=PKW(P1,8), pw3[1]=PKW(P1,10), pw3); \
    VRD(7); SBAR(); GAPA(C1=__builtin_amdgcn_mfma_f32_32x32x16_bf16(kf[7],qr[3],C1,0,0,0),   P1[14],P1[15],0.f,0.f,       pw3[2]=PKW(P1,12),pw3[3]=PKW(P1,14), pw3); \
    l_reg+=sacc; \
    if(GK){DMA_K((t)+3,sl_cur);} if(GV){DMA_V((t)+1,sl_next);} \
    CMASK(C0,C1,t); \
    { float a=MX3(C0[0],C0[1],C1[0]),b=MX3(C0[2],C0[3],C1[1]); a=MX3(a,C1[2],C1[3]); \
      _Pragma("unroll") for(int r=4;r<16;r+=4){a=MX3(a,C0[r],C0[r+1]);b=MX3(b,C0[r+2],C0[r+3]);a=MX3(a,C1[r],C1[r+1]);b=MX3(b,C1[r+2],C1[r+3]);} \
      float rm=__builtin_fmaxf(a,b); { auto rr=__builtin_amdgcn_permlane32_swap(__float_as_uint(rm),__float_as_uint(rm),false,false); rm=__builtin_fmaxf(__uint_as_float(rr[0]),__uint_as_float(rr[1])); } \
      resc=false; \
      if(__builtin_expect(__any(rm>(float)THRL),0)){ const float dl=__builtin_fmaxf(rm,0.f); mhat+=dl; \
        _Pragma("unroll") for(int r=0;r<16;++r){C0[r]-=dl;C1[r]-=dl;} \
        _Pragma("unroll") for(int r=0;r<16;++r)negm[r]=-mhat; asm volatile("":"+v"(negm)); \
        const float f=__builtin_amdgcn_exp2f(-dl); l_reg*=f; if(hi==0)wsf[r32]=f; resc=true; } } \
    SBAR(); \
    GAPB(o[0]=__builtin_amdgcn_mfma_f32_32x32x16_bf16(PAF(0),VFR(0),o[0],0,0,0), C0,0); \
    GAPB(o[1]=__builtin_amdgcn_mfma_f32_32x32x16_bf16(PAF(0),VFR(4),o[1],0,0,0), C0,4); \
    KRD(GL,0); GAPB(o[0]=__builtin_amdgcn_mfma_f32_32x32x16_bf16(PAF(1),VFR(1),o[0],0,0,0), C0,8); \
    KRD(GL,1); GAPB(o[1]=__builtin_amdgcn_mfma_f32_32x32x16_bf16(PAF(1),VFR(5),o[1],0,0,0), C0,12); \
    KRD(GL,2); GAPB(o[0]=__builtin_amdgcn_mfma_f32_32x32x16_bf16(PAF(2),VFR(2),o[0],0,0,0), C1,0); \
    KRD(GL,3); GAPB(o[1]=__builtin_amdgcn_mfma_f32_32x32x16_bf16(PAF(2),VFR(6),o[1],0,0,0), C1,4); \
    GAPB(o[0]=__builtin_amdgcn_mfma_f32_32x32x16_bf16(PAF(3),VFR(3),o[0],0,0,0), C1,8); \
    GAPB(o[1]=__builtin_amdgcn_mfma_f32_32x32x16_bf16(PAF(3),VFR(7),o[1],0,0,0), C1,12); \
    }while(0)
  int t=1;
  #undef CMASK
  #define CMASK(P0,P1,t) do{}while(0)
  for(;t+5<NT;t+=2){
    STEP(pB0,pB1,pA0,pA1,t,true,true,true);     WAIT_BAR(2); RESC(); ROT();
    STEP(pA0,pA1,pB0,pB1,t+1,true,true,true);   WAIT_BAR(2); RESC(); ROT();
  }
  #undef CMASK
  #define CMASK(P0,P1,t) do{int jb_=(t)-(NT-4); if(jb_>=0)cmask(P0,P1,jb_,qrel,hi);}while(0)
  #define ENDW(tt) do{ if((tt)+3<NT){WAIT_BAR(2);} else if((tt)+2<NT){WAIT_BAR(1);} else {WAIT_BAR(0);} }while(0)
  for(;t+1<NT;t+=2){
    STEP(pB0,pB1,pA0,pA1,t,(t+3<NT),(t+1<NT),(t+1<NT));       ENDW(t);   RESC(); ROT();
    STEP(pA0,pA1,pB0,pB1,t+1,(t+4<NT),(t+2<NT),(t+2<NT));     ENDW(t+1); RESC(); ROT();
  }
  STEP(pB0,pB1,pA0,pA1,NT-1,false,false,false); RESC();
  { float sacc=pB0[0]+pB0[1]; _Pragma("unroll") for(int r=2;r<16;++r)sacc+=pB0[r]; _Pragma("unroll") for(int r=0;r<16;++r)sacc+=pB1[r]; l_reg+=sacc;
    pw0=(u32x4){PKW(pB0,0),PKW(pB0,2),PKW(pB0,4),PKW(pB0,6)};pw1=(u32x4){PKW(pB0,8),PKW(pB0,10),PKW(pB0,12),PKW(pB0,14)};pw2=(u32x4){PKW(pB1,0),PKW(pB1,2),PKW(pB1,4),PKW(pB1,6)};pw3=(u32x4){PKW(pB1,8),PKW(pB1,10),PKW(pB1,12),PKW(pB1,14)};
    SBAR(); pv(o,vb0+sl_cur,PAF(0),PAF(1),PAF(2),PAF(3)); }
  #undef PKW
  #undef PAF
  #undef VFR
  #undef PIN
  #undef MX3
  #undef GAPA
  #undef GAPB
  #undef EX
  #undef VRD
  #undef KRD
  #undef STEP
  #undef ENDW
  {auto rr=__builtin_amdgcn_permlane32_swap(__float_as_uint(l_reg),__float_as_uint(l_reg),false,false);l_reg=__uint_as_float(rr[0])+__uint_as_float(rr[1]);}
  if(hi==0)wsf[32+r32]=l_reg;asm volatile("s_waitcnt lgkmcnt(0)":::"memory");
  float rli[16];
  #pragma unroll
  for(int r=0;r<16;++r)rli[r]=__builtin_amdgcn_rcpf(wsf[32+crow(r,hi)]);
  bf16*Ow=O+(rowbase+q0+wid*QBLK)*DM+ocol;
  { bf16*stg=(bf16*)(shm+((mode&1)?LDS_OST:LDS_STA))+wid*2048;
    #pragma unroll
    for(int r=0;r<16;++r){const int orow=crow(r,hi);
      #pragma unroll
      for(int d0=0;d0<2;++d0)stg[orow*64+d0*32+r32]=__float2bfloat16(o[d0][r]*rli[r]);}
    asm volatile("s_waitcnt lgkmcnt(0)":::"memory");
#ifndef ATT_NO_EPI2
    if(mode&1){ const bf16*sa=(const bf16*)(shm+LDS_STA)+wid*2048; bf16*sc=(bf16*)(shm+LDS_STC)+wid*2048;
      int ln=lane; asm volatile("":"+v"(ln));
      #pragma unroll 1
      for(int i=0;i<4;++i){const int row=i*8+(ln>>3),ch=ln&7,idx=row*64+ch*8; const u32x4 av=*(const u32x4*)(sa+idx),bv=*(const u32x4*)(stg+idx);
        float c[8];
        #pragma unroll
        for(int k=0;k<4;++k){ c[2*k]=__uint_as_float(av[k]<<16)-lam*__uint_as_float(bv[k]<<16); c[2*k+1]=__uint_as_float(av[k]&0xffff0000u)-lam*__uint_as_float(bv[k]&0xffff0000u); }
        if(mode==1){ u32x4 w; w[0]=cvtpk_s(c[0],c[1]);w[1]=cvtpk_s(c[2],c[3]);w[2]=cvtpk_s(c[4],c[5]);w[3]=cvtpk_s(c[6],c[7]); *(u32x4*)(sc+idx)=w; }
        else { const u32x4 cv=*(const u32x4*)(sc+idx); float c0[8];
          #pragma unroll
          for(int k=0;k<4;++k){ c0[2*k]=__uint_as_float(cv[k]<<16); c0[2*k+1]=__uint_as_float(cv[k]&0xffff0000u); }
          float ss=0.f;
          #pragma unroll
          for(int k=0;k<8;++k)ss+=c0[k]*c0[k]+c[k]*c[k];
          ss+=__shfl_xor(ss,1);ss+=__shfl_xor(ss,2);ss+=__shfl_xor(ss,4);
          const float rs=1.0f/sqrtf(ss*(1.0f/128.0f)+1e-6f);
          u32x4 w0,w1;
          w0[0]=cvtpk_s(c0[0]*rs,c0[1]*rs);w0[1]=cvtpk_s(c0[2]*rs,c0[3]*rs);w0[2]=cvtpk_s(c0[4]*rs,c0[5]*rs);w0[3]=cvtpk_s(c0[6]*rs,c0[7]*rs);
          w1[0]=cvtpk_s(c[0]*rs,c[1]*rs);w1[1]=cvtpk_s(c[2]*rs,c[3]*rs);w1[2]=cvtpk_s(c[4]*rs,c[5]*rs);w1[3]=cvtpk_s(c[6]*rs,c[7]*rs);
          *(u32x4*)(Ow+(long)row*DM+ch*8)=w0; *(u32x4*)(Ow+(long)row*DM+64+ch*8)=w1; }
      }
      asm volatile("s_waitcnt lgkmcnt(0)":::"memory");
    }
#endif
    }
  asm volatile("s_waitcnt lgkmcnt(0)\n\ts_barrier":::"memory");
  #undef DMA_K
  #undef DMA_V
  #undef CMASK
  #undef START
  #undef RESC
  #undef ROT
}
constexpr int ATTN_LDS_BYTES=LDS_BYTES;
#undef SBAR
#undef WAIT_BAR
}
constexpr int NWAVES = 8;
constexpr int TOK = 16384, DMODEL = 1024, NBATCH = 4, SEQL = 4096, MEMT = 1024  , DFF = 2816;
constexpr size_t MiB = 1u << 20;
constexpr size_t WS_CTL = 0, CTL_ZERO_BYTES = 1 * MiB;
constexpr size_t WS_RSTD0 = 1 * MiB, WS_RSTDM = WS_RSTD0 + 65536, WS_WAB = WS_RSTD0 + 131072, WS_GVAL = WS_RSTD0 + 262144, WS_BETA = WS_GVAL + 524288, WS_RCOS = WS_BETA + 524288, WS_RSIN = WS_RCOS + 524288;
constexpr size_t WS_SS1 = 4 * MiB, WS_SS2 = 5 * MiB, WS_SS3 = 6 * MiB, WS_KVC = 7 * MiB, WS_MEMB = 9 * MiB;
constexpr size_t WS_W1 = 11 * MiB, WS_WGZ = 23 * MiB, WS_WOUTA = 29 * MiB, WS_WOUTB = 31 * MiB, WS_WO = 33 * MiB, WS_WCQ = 35 * MiB, WS_WCKV = 36 * MiB, WS_WCO = 38 * MiB, WS_WFFI = 39 * MiB, WS_WFFO = 50 * MiB;
constexpr size_t WS_XB = 56 * MiB;
constexpr size_t WS_QB = 88 * MiB, WS_KB = 120 * MiB, WS_VB = 152 * MiB, WS_VA = 184 * MiB, WS_OA = 216 * MiB, WS_END = 256 * MiB;
constexpr size_t WS_X1 = 88 * MiB, WS_X1B = 152 * MiB, WS_MERGED = 184 * MiB, WS_QC = 216 * MiB, WS_OC = 232 * MiB, WS_ACT = 88 * MiB;
static_assert(WS_RSIN + 524288 <= WS_SS1 && WS_WFFO + (size_t)1024 * DFF * 2 <= WS_XB && WS_ACT + (size_t)TOK * DFF * 2 <= WS_VA && WS_OA + (size_t)TOK * 2048 <= WS_END - 8 * MiB, "d_ws map");
constexpr int CW_TMO = 0, CW_CODE = 1, CW_BAR = 4096, CW_QUEUE = 8192, CW_DBG = 8256;
constexpr int SCR_BYTES = 162816, LDSCTL_OFF = SCR_BYTES, MISC_OFF = LDSCTL_OFF + 320, LDS_BYTES = 163840;

#define GAS __attribute__((address_space(1)))
#define LAS __attribute__((address_space(3)))
typedef unsigned short bf16;
typedef unsigned v4u __attribute__((ext_vector_type(4)));
typedef unsigned v2u __attribute__((ext_vector_type(2)));
typedef float f32x4 __attribute__((ext_vector_type(4)));
typedef float f32x16 __attribute__((ext_vector_type(16)));
typedef short bf16x8 __attribute__((ext_vector_type(8)));
typedef short s16x4 __attribute__((ext_vector_type(4)));
#define GAS __attribute__((address_space(1)))
#define LAS __attribute__((address_space(3)))
typedef unsigned short bf16;
typedef unsigned v4u __attribute__((ext_vector_type(4)));
typedef float f32x4 __attribute__((ext_vector_type(4)));
typedef short bf16x8 __attribute__((ext_vector_type(8)));
typedef GAS unsigned gu32;
typedef GAS unsigned long long gu64;
#define RLX_AGENT __ATOMIC_RELAXED, __HIP_MEMORY_SCOPE_AGENT
#define LDS_WAIT() asm volatile("s_waitcnt lgkmcnt(0)" ::: "memory")
#define VM_WAIT() asm volatile("s_waitcnt vmcnt(0)" ::: "memory")
__device__ __forceinline__ unsigned long long rt() { return __builtin_amdgcn_s_memrealtime(); }
__device__ __forceinline__ unsigned f2bf(float f) { unsigned u = __builtin_bit_cast(unsigned, f); return (u + 0x7fffu + ((u >> 16) & 1u)) >> 16; }
__device__ __forceinline__ unsigned pk2(float lo, float hi) { return f2bf(lo) | (f2bf(hi) << 16); }

#define XB_TMO      128
#define XB_XCNT(j)  (256  + 64 * (j))
#define XB_XSUB(j)  (1280 + 64 * (j))
#define XB_XGEN(j)  (2304 + 64 * (j))
#define XB_TOP      3328
#define XB_TOPGEN   3392
#define XCD_BAR_WORDS 3456
#define XB_SPIN_CAP (1u << 18)

__device__ __forceinline__ unsigned xb_ld(unsigned* p)              { return __hip_atomic_load(p, __ATOMIC_RELAXED, __HIP_MEMORY_SCOPE_AGENT); }
__device__ __forceinline__ unsigned xb_add(unsigned* p, unsigned v) { return __hip_atomic_fetch_add(p, v, __ATOMIC_RELAXED, __HIP_MEMORY_SCOPE_AGENT); }
__device__ __forceinline__ unsigned xb_xcc_id() { return (unsigned)__builtin_amdgcn_s_getreg((3 << 11) | 20) & 0xFu; }
#define XB_SPIN(cond, bar) do { unsigned _sp = 0; while (cond) { __builtin_amdgcn_s_sleep(1); \
    if ((++_sp & 255u) == 0u) { if (xb_ld(&(bar)[XB_TMO])) break; if (_sp > XB_SPIN_CAP) { atomicAdd(&(bar)[XB_TMO], 1u); break; } } } } while (0)

struct XcdBarrier {
    unsigned* bar; unsigned x;
    volatile LAS unsigned* st;
};

__device__ __forceinline__ XcdBarrier xcd_barrier_post(unsigned* bar, volatile LAS unsigned* st, const bool t0) {
    XcdBarrier b; b.bar = bar; b.x = xb_xcc_id(); b.st = st;
    if (t0) (void)xb_add(&bar[XB_XCNT(b.x)], 1u);
    return b;
}
__device__ __forceinline__ void xcd_barrier_complete(unsigned* bar, unsigned x, unsigned& nloc, unsigned& nx) {
    const unsigned G = gridDim.x * gridDim.y * gridDim.z;
    unsigned sum, cnt, mine, sp = 0u;
    for (;;) {
        sum = 0u; cnt = 0u; mine = 0u;
#pragma unroll
        for (unsigned j = 0; j < 16; ++j) { const unsigned c = xb_ld(&bar[XB_XCNT(j)]); sum += c; cnt += (c > 0u) ? 1u : 0u; mine = (j == x) ? c : mine; }
        if (sum == G) break;
        __builtin_amdgcn_s_sleep(1);
        if ((++sp & 255u) == 0u) { if (xb_ld(&bar[XB_TMO])) break; if (sp > XB_SPIN_CAP) { atomicAdd(&bar[XB_TMO], 1u); break; } }
    }
    nloc = mine > 0u ? mine : 1u; nx = cnt > 0u ? cnt : 1u;
}

__device__ __forceinline__ void xcd_barrier(const XcdBarrier& b, const bool t0) {
    asm volatile("s_waitcnt vmcnt(0)" ::: "memory");
    __syncthreads();
    if (t0) {
        unsigned* bar = b.bar;
        __builtin_amdgcn_s_waitcnt(0);
        unsigned nloc = b.st[0], nx = b.st[1];
        if (nloc == 0u) { xcd_barrier_complete(bar, b.x, nloc, nx); b.st[0] = nloc; b.st[1] = nx; }
        const unsigned old = xb_add(&bar[XB_XSUB(b.x)], 1u);
        const unsigned gen = old / nloc;
        if (old + 1u == (gen + 1u) * nloc) {
            __builtin_amdgcn_fence(__ATOMIC_RELEASE, "agent");
            asm volatile("s_waitcnt vmcnt(0)" ::: "memory");
            const unsigned og = xb_add(&bar[XB_TOP], 1u);
            const unsigned tg = og / nx;
            if (og + 1u == (tg + 1u) * nx) xb_add(&bar[XB_TOPGEN], 1u);
            else XB_SPIN(xb_ld(&bar[XB_TOPGEN]) == tg, bar);
            __builtin_amdgcn_fence(__ATOMIC_ACQUIRE, "agent");
            xb_add(&bar[XB_XGEN(b.x)], 1u);
            asm volatile("s_waitcnt vmcnt(0)" ::: "memory");
        } else {
            XB_SPIN(xb_ld(&bar[XB_XGEN(b.x)]) == gen, bar);
            __builtin_amdgcn_fence(__ATOMIC_ACQUIRE, "agent");
            asm volatile("s_waitcnt vmcnt(0)" ::: "memory");
        }
    }
    __syncthreads();
}
struct Args { const void* in[27]; float* out; unsigned char* ws; float invf[8]; };
struct Frame {
    LAS unsigned char* lds; volatile LAS unsigned* MISC; gu32* ctl;
    int wave, vcu, G;
};
__device__ __forceinline__ float wave_sum(float v) {
#pragma unroll
    for (int o = 1; o < 64; o <<= 1) v += __shfl_xor(v, o);
    return v;
}
__device__ __forceinline__ unsigned pk2r(float lo, float hi) { typedef float f2 __attribute__((ext_vector_type(2))); typedef __bf16 b2 __attribute__((ext_vector_type(2))); f2 v = {lo, hi}; b2 b = __builtin_convertvector(v, b2); return __builtin_bit_cast(unsigned, b); }

__device__ __forceinline__ void tr_item(const float* W, int ldw, int scol0, int K, bf16* WT, int drow0, const float* gain, int gmask, float gscale, int mode, LAS float* scr, int item, int nblk, int lane) {
    const int kb = item / nblk, nb = item - kb * nblk, k0 = 64 * kb, n0 = 32 * nb;
    int sc = scol0 + n0;
    if (mode == 3) { const int j = n0 >> 8, wi = n0 & 255; sc = (wi < 128) ? j * 128 + wi : DFF + j * 128 + (wi - 128); }
#pragma unroll 8
    for (int i = 0; i < 32; ++i) { const int kk = 2 * i + (lane >> 5); const float g = gain ? gain[(k0 + kk) & gmask] * gscale : gscale; scr[kk * 33 + (lane & 31)] = W[(size_t)(k0 + kk) * ldw + sc + (lane & 31)] * g; }
    LDS_WAIT(); asm volatile("" ::: "memory");
    const int c = lane & 7;
#pragma unroll
    for (int j = 0; j < 4; ++j) { const int n = (lane >> 3) + 8 * j; const LAS float* s = scr + (8 * c) * 33 + n;
        v4u o; o.x = pk2r(s[0 * 33], s[1 * 33]); o.y = pk2r(s[2 * 33], s[3 * 33]); o.z = pk2r(s[4 * 33], s[5 * 33]); o.w = pk2r(s[6 * 33], s[7 * 33]);
        *(GAS v4u*)(WT + (size_t)(drow0 + n0 + n) * K + k0 + 8 * c) = o; }
    LDS_WAIT(); asm volatile("" ::: "memory");
}
#define TR_MAT(W, ldw, scol0, K, WT, drow0, nrows, gain, gmask, gscale, mode) do { const int nblk_ = (nrows) / 32, nit_ = ((K) / 64) * nblk_; \
    for (int it_ = (gw - base % NGW + NGW) % NGW; it_ < nit_; it_ += NGW) tr_item((W), (ldw), (scol0), (K), (WT), (drow0), (gain), (gmask), (gscale), (mode), scr, it_, nblk_, lane); base += nit_; } while (0)
__device__ __forceinline__ void row_to_bf16(const float* xrow, bf16* orow, float* rstd_out, int lane) {
    const GAS f32x4* xr = (const GAS f32x4*)xrow + lane; f32x4 v[4]; float s = 0.f;
#pragma unroll
    for (int j = 0; j < 4; ++j) { v[j] = xr[64 * j]; s += (v[j].x * v[j].x + v[j].y * v[j].y) + (v[j].z * v[j].z + v[j].w * v[j].w); }
    s = wave_sum(s);
    GAS v2u* o8 = (GAS v2u*)orow + lane;
#pragma unroll
    for (int j = 0; j < 4; ++j) { v2u w; w.x = pk2r(v[j].x, v[j].y); w.y = pk2r(v[j].z, v[j].w); o8[64 * j] = w; }
    if (lane == 0) *rstd_out = 1.0f / sqrtf(s * (1.0f / 1024.0f) + 1e-6f);
}
constexpr float C2Q = 0.125f * 1.4426950408889634f;
constexpr float C2X = 0.08838834764831845f * 1.4426950408889634f;
__device__ __forceinline__ void p0_prologue(Frame& F, const Args& A, unsigned char* ws) {
    LAS float* scr = (LAS float*)(F.lds + F.wave * 16384); const int lane = lane_id(), tid = F.wave * 64 + lane;
    const int gw = F.vcu * NWAVES + F.wave, NGW = F.G * NWAVES; int base = 0;
    const float* g_mix = (const float*)A.in[3]; const float* w_in = (const float*)A.in[4];
    TR_MAT(w_in, 7184, 0, 1024, (bf16*)(ws + WS_W1), 0, 3072, g_mix, 1023, 1.0f, 0);
    TR_MAT(w_in, 7184, 4112, 1024, (bf16*)(ws + WS_W1), 3072, 3072, g_mix, 1023, 1.0f, 0);
    TR_MAT((const float*)A.in[14], 2048, 0, 1024, (bf16*)(ws + WS_WGZ), 0, 2048, g_mix, 1023, 1.0f, 0);
    TR_MAT(w_in, 7184, 3072, 1024, (bf16*)(ws + WS_WGZ), 2048, 1024, g_mix, 1023, 1.0f, 0);
    TR_MAT((const float*)A.in[15], 1024, 0, 1024, (bf16*)(ws + WS_WOUTA), 0, 1024, (const float*)A.in[8], 127, 1.0f, 0);
    TR_MAT((const float*)A.in[16], 1024, 0, 1024, (bf16*)(ws + WS_WOUTB), 0, 1024, (const float*)A.in[13], 127, 0.8f, 0);
    TR_MAT((const float*)A.in[17], 1024, 0, 1024, (bf16*)(ws + WS_WO), 0, 1024, (const float*)nullptr, 0, 1.0f, 0);
    TR_MAT((const float*)A.in[20], 512, 0, 1024, (bf16*)(ws + WS_WCQ), 0, 512, (const float*)A.in[18], 1023, C2X, 0);
    TR_MAT((const float*)A.in[21], 1024, 0, 1024, (bf16*)(ws + WS_WCKV), 0, 1024, (const float*)A.in[19], 1023, 1.0f, 0);
    TR_MAT((const float*)A.in[22], 1024, 0, 512, (bf16*)(ws + WS_WCO), 0, 1024, (const float*)nullptr, 0, 1.0f, 0);
    TR_MAT((const float*)A.in[24], 2 * DFF, 0, 1024, (bf16*)(ws + WS_WFFI), 0, 2 * DFF, (const float*)A.in[23], 1023, 1.0f, 3);
    TR_MAT((const float*)A.in[25], 1024, 0, DFF, (bf16*)(ws + WS_WFFO), 0, 1024, (const float*)nullptr, 0, 1.0f, 0);
    const float* x = (const float*)A.in[0]; const float* mem = (const float*)A.in[1];
    for (int m = gw; m < TOK; m += NGW) row_to_bf16(x + (size_t)m * 1024, (bf16*)(ws + WS_XB) + (size_t)m * 1024, (float*)(ws + WS_RSTD0) + m, lane);
    for (int m = gw; m < MEMT; m += NGW) row_to_bf16(mem + (size_t)m * 1024, (bf16*)(ws + WS_MEMB) + (size_t)m * 1024, (float*)(ws + WS_RSTDM) + m, lane);
    const int gt = F.vcu * (NWAVES * 64) + tid, NGT = F.G * NWAVES * 64;
    const int* pos = (const int*)A.in[2];
    for (int i = gt; i < TOK * 8; i += NGT) { const float ang = (float)pos[i >> 3] * A.invf[i & 7]; double rev = (double)ang * 0.15915494309189535; rev -= (double)(long long)rev; const float rf = (float)rev;
        ((float*)(ws + WS_RCOS))[i] = __builtin_amdgcn_cosf(rf); ((float*)(ws + WS_RSIN))[i] = __builtin_amdgcn_sinf(rf); }
    for (int i = gt; i < 16 * 1024; i += NGT) { const int n = i >> 10, k = i & 1023; ((bf16*)(ws + WS_WAB))[i] = (bf16)(pk2r(w_in[(size_t)k * 7184 + 4096 + n] * g_mix[k], 0.f) & 0xffffu); }
}
__device__ __forceinline__ void ab_unit(Frame& F, const Args& A, unsigned char* ws, int mu) {
    typedef float f4 __attribute__((ext_vector_type(4)));
    const int rb = F.wave & 3, kh = F.wave >> 2, t0 = mu * 64, l = lane_id(), tid = F.wave * 64 + l;
    const bf16* xb = (const bf16*)(ws + WS_XB) + (size_t)(t0 + 16 * rb + (l & 15)) * 1024 + kh * 512 + 8 * (l >> 4);
    const bf16* wb = (const bf16*)(ws + WS_WAB) + (size_t)(l & 15) * 1024 + kh * 512 + 8 * (l >> 4);
    f4 acc = {0.f, 0.f, 0.f, 0.f};
#pragma unroll 4
    for (int ks = 0; ks < 16; ++ks) { const bf16x8 a = *(const bf16x8*)(xb + ks * 32), b = *(const bf16x8*)(wb + ks * 32); acc = __builtin_amdgcn_mfma_f32_16x16x32_bf16(a, b, acc, 0, 0, 0); }
    LAS float* red = (LAS float*)F.lds;
#pragma unroll
    for (int r = 0; r < 4; ++r) red[(kh * 4 + rb) * 256 + (4 * (l >> 4) + r) * 16 + (l & 15)] = acc[r];
    __syncthreads();
    const float* a_log = (const float*)A.in[6]; const float* dt_bias = (const float*)A.in[7];
#pragma unroll
    for (int j = 0; j < 2; ++j) { const int o = tid + 512 * j, row = o >> 4, col = o & 15;
        float v = red[(row >> 4) * 256 + (row & 15) * 16 + col] + red[(4 + (row >> 4)) * 256 + (row & 15) * 16 + col];
        v *= ((const float*)(ws + WS_RSTD0))[t0 + row];
        if (col < 8) { const float xx = v + dt_bias[col]; const float sp = xx > 20.f ? xx : log1pf(__expf(xx)); ((float*)(ws + WS_GVAL))[(size_t)(t0 + row) * 8 + col] = -__expf(a_log[col]) * sp; }
        else ((float*)(ws + WS_BETA))[(size_t)(t0 + row) * 8 + (col - 8)] = 1.0f / (1.0f + __expf(-v)); }
    __syncthreads();
}
__device__ __forceinline__ void final_rows(Frame& F, float* out, const float* ss3, const float* g_final) {
    const int gw = F.vcu * NWAVES + F.wave, NGW = F.G * NWAVES, lane = lane_id();
    f32x4 g[4];
#pragma unroll
    for (int j = 0; j < 4; ++j) g[j] = *((const GAS f32x4*)g_final + lane + 64 * j);
    for (int m = gw; m < TOK; m += NGW) { const float rs = pg8::rstd16(ss3 + (size_t)m * 16); GAS f32x4* o = (GAS f32x4*)(out + (size_t)m * 1024) + lane;
#pragma unroll
        for (int j = 0; j < 4; ++j) { const f32x4 v = o[64 * j]; o[64 * j] = v * rs * g[j]; } }
}
#ifndef TPROBE
#define TPROBE -1
#endif
#define GDN_TIME (TPROBE >= 100)
namespace gdn {
constexpr int L_RV = 0, L_RK = 32768, L_LM = 65536, L_KN = 81920, L_QN = 98304, L_QD = 114688, L_KDT = 131072, L_AT = 147456, L_GC = 155648, L_BYTES = 156672;
constexpr int IMG_W = 0, IMG_QD = 16384, IMG_KDT = 32768, IMG_U = 49152, IMG_AT = 65536, IMG_BYTES = 71680, SC_O = 2 * IMG_BYTES, SC_GL = SC_O + 16384, SC_BYTES = SC_GL + 256;
static_assert(SC_BYTES <= SCR_BYTES, "gdn scan LDS");
constexpr size_t WS_ATG = 11 * MiB, WS_HALO = 248 * MiB, WS_GLAST = 253 * MiB;
__device__ __forceinline__ int at_off(int bi, int row, int chunk) { return bi * 2048 + row * 64 + ((chunk ^ ((row >> 2) & 3)) << 4); }

static_assert(L_BYTES <= SCR_BYTES, "gdn LDS");
__device__ __forceinline__ int sw256(int row, int chunk) { return row * 256 + ((chunk ^ (row & 15)) << 4); }
__device__ __forceinline__ int sw128(int row, int chunk) { return row * 128 + ((chunk ^ ((row >> 1) & 7)) << 4); }
__device__ __forceinline__ int crow(int r, int hi) { return (r & 3) + 8 * (r >> 2) + 4 * hi; }
__device__ __forceinline__ bf16x8 frag2(const LAS unsigned char* tile, int off0, int off1) { const v2u a = *(const LAS v2u*)(tile + off0), b = *(const LAS v2u*)(tile + off1); v4u w = {a.x, a.y, b.x, b.y}; return __builtin_bit_cast(bf16x8, w); }
__device__ __forceinline__ bf16x8 packacc(const f32x16& v, int s) { v4u w; w.x = pk2r(v[8 * s + 0], v[8 * s + 1]); w.y = pk2r(v[8 * s + 2], v[8 * s + 3]); w.z = pk2r(v[8 * s + 4], v[8 * s + 5]); w.w = pk2r(v[8 * s + 6], v[8 * s + 7]); return __builtin_bit_cast(bf16x8, w); }
__device__ __forceinline__ float siluf_(float x) { return x / (1.0f + __expf(-x)); }

constexpr int SOLVE_NGRP = 528, SOLVE_PF = 10, SOLVE_RING = SOLVE_PF + 1;
constexpr int grp_row(int g) { int i = 1; for (;;) { const int n = (i + 3) / 4; if (g < n) return i; g -= n; ++i; } }
constexpr int grp_m4(int g) { int i = 1; for (;;) { const int n = (i + 3) / 4; if (g < n) return g; g -= n; ++i; } }
template <int G> __device__ __forceinline__ void solve_load(f32x4 (&buf)[SOLVE_RING], const LAS unsigned char* lm) {
    if constexpr (G < SOLVE_NGRP) { constexpr int r = grp_row(G), m = grp_m4(G); buf[G % SOLVE_RING] = *(const LAS f32x4*)(lm + r * 256 + m * 16); }
}
template <int G> __device__ __forceinline__ void solve_step(float (&x)[64], f32x4 (&buf)[SOLVE_RING], const LAS unsigned char* lm) {
    solve_load<G + SOLVE_PF>(buf, lm);
    constexpr int i = grp_row(G), m4 = grp_m4(G); const f32x4 lq = buf[G % SOLVE_RING];
    if constexpr (4 * m4 + 0 < i) x[i] -= lq[0] * x[4 * m4 + 0];
    if constexpr (4 * m4 + 1 < i) x[i] -= lq[1] * x[4 * m4 + 1];
    if constexpr (4 * m4 + 2 < i) x[i] -= lq[2] * x[4 * m4 + 2];
    if constexpr (4 * m4 + 3 < i) x[i] -= lq[3] * x[4 * m4 + 3];
    __builtin_amdgcn_sched_barrier(0);
}
template <int... Gs> __device__ __forceinline__ void solve_all(float (&x)[64], f32x4 (&buf)[SOLVE_RING], const LAS unsigned char* lm, std::integer_sequence<int, Gs...>) { (solve_step<Gs>(x, buf, lm), ...); }
template <int... Gs> __device__ __forceinline__ void solve_pro(f32x4 (&buf)[SOLVE_RING], const LAS unsigned char* lm, std::integer_sequence<int, Gs...>) { (solve_load<Gs>(buf, lm), ...); }

__device__ __forceinline__ void prep_unit(Frame& F, const Args& A, unsigned char* ws, float* dout, int b, int h, int ch) {
    LAS unsigned char* L = F.lds; const int wave = F.wave;
    bf16* QA = (bf16*)dout; bf16* KA = (bf16*)dout + (size_t)TOK * 1024; bf16* VA = (bf16*)(ws + WS_VA); bf16* OA = (bf16*)(ws + WS_OA); const bf16* HALO = (const bf16*)(ws + WS_HALO);
    const float* conv_w = (const float*)A.in[5]; const float* gval = (const float*)(ws + WS_GVAL); const float* beta = (const float*)(ws + WS_BETA);
    LAS float* RV = (LAS float*)(L + L_RV); LAS float* RK = (LAS float*)(L + L_RK); LAS float* LM = (LAS float*)(L + L_LM); LAS float* GC = (LAS float*)(L + L_GC);
    {
        const int tb0 = ch * 64; const size_t grow0 = (size_t)b * SEQL + tb0;
        int lv = lane_id(); asm volatile("" : "+v"(lv));
        const int hi = lv >> 5, r32 = lv & 31;
        const int l = lv; float gcs = gval[(grow0 + l) * 8 + h];
#pragma unroll
        for (int o = 1; o < 64; o <<= 1) { const float t = __shfl_up(gcs, o); if (l >= o) gcs += t; }
        const float glast = __shfl(gcs, 63); const float egc_l = __expf(gcs), ekd_l = __expf(glast - gcs), bt_l = beta[(grow0 + l) * 8 + h];
        if (wave == 0) { GC[l] = gcs; GC[64 + l] = egc_l; GC[128 + l] = ekd_l; GC[192 + l] = bt_l; }
        const int g = lv & 15, r0 = (wave << 2) + (lv >> 4);
#pragma unroll
        for (int half = 0; half < 2; ++half) { const int c = r0 + 32 * half; const float egc = __shfl(egc_l, c), ekd = __shfl(ekd_l, c), bt = __shfl(bt_l, c);
#pragma unroll
            for (int X = 0; X < 3; ++X) { const bf16* src = (X == 0 ? QA : X == 1 ? KA : VA) + (grow0 + c) * 1024 + h * 128 + 8 * g; const float* cw = conv_w + X * 1024 + h * 128 + 8 * g;
                float o[8];
#pragma unroll
                for (int e = 0; e < 8; ++e) o[e] = 0.f;
#pragma unroll
                for (int jj = 0; jj < 4; ++jj) { v4u raw = {0u, 0u, 0u, 0u}; { const int rel = c - 3 + jj; if (rel >= 0) raw = *(const GAS v4u*)(src + (jj - 3) * 1024); else if (ch > 0) raw = *(const GAS v4u*)(HALO + ((size_t)((b * 64 + ch - 1) * 3 + (rel + 3))) * 3072 + X * 1024 + h * 128 + 8 * g); }
                    const f32x4 w0 = *(const GAS f32x4*)(cw + jj * 3072), w1 = *(const GAS f32x4*)(cw + jj * 3072 + 4);
                    o[0] += w0[0] * __uint_as_float(raw.x << 16); o[1] += w0[1] * __uint_as_float(raw.x & 0xffff0000u); o[2] += w0[2] * __uint_as_float(raw.y << 16); o[3] += w0[3] * __uint_as_float(raw.y & 0xffff0000u);
                    o[4] += w1[0] * __uint_as_float(raw.z << 16); o[5] += w1[1] * __uint_as_float(raw.z & 0xffff0000u); o[6] += w1[2] * __uint_as_float(raw.w << 16); o[7] += w1[3] * __uint_as_float(raw.w & 0xffff0000u); }
                float ss = 0.f;
#pragma unroll
                for (int e = 0; e < 8; ++e) { o[e] = siluf_(o[e]); ss += o[e] * o[e]; }
                if (X < 2) { ss += __shfl_xor(ss, 1); ss += __shfl_xor(ss, 2); ss += __shfl_xor(ss, 4); ss += __shfl_xor(ss, 8); const float rn = 1.0f / sqrtf(ss + 1e-6f) * (X == 0 ? 0.08838834764831845f : 1.0f);
#pragma unroll
                    for (int e = 0; e < 8; ++e) o[e] *= rn; }
                if (X == 0) { v4u w = {pk2r(o[0], o[1]), pk2r(o[2], o[3]), pk2r(o[4], o[5]), pk2r(o[6], o[7])}; *(LAS v4u*)(L + L_QN + sw256(c, g)) = w;
                    v4u wd = {pk2r(o[0] * egc, o[1] * egc), pk2r(o[2] * egc, o[3] * egc), pk2r(o[4] * egc, o[5] * egc), pk2r(o[6] * egc, o[7] * egc)}; *(LAS v4u*)(L + L_QD + sw256(c, g)) = wd; }
                else if (X == 1) { v4u w = {pk2r(o[0], o[1]), pk2r(o[2], o[3]), pk2r(o[4], o[5]), pk2r(o[6], o[7])}; *(LAS v4u*)(L + L_KN + sw256(c, g)) = w;
#pragma unroll
                    for (int e = 0; e < 8; ++e) *(LAS bf16*)(L + L_KDT + sw128(8 * g + e, c >> 3) + (c & 7) * 2) = (bf16)(pk2r(o[e] * ekd, 0.f) & 0xffffu);
                    const float f = bt * egc; *(LAS f32x4*)(RK + c * 128 + 8 * g) = (f32x4){o[0] * f, o[1] * f, o[2] * f, o[3] * f}; *(LAS f32x4*)(RK + c * 128 + 8 * g + 4) = (f32x4){o[4] * f, o[5] * f, o[6] * f, o[7] * f}; }
                else { *(LAS f32x4*)(RV + c * 128 + 8 * g) = (f32x4){o[0] * bt, o[1] * bt, o[2] * bt, o[3] * bt}; *(LAS f32x4*)(RV + c * 128 + 8 * g + 4) = (f32x4){o[4] * bt, o[5] * bt, o[6] * bt, o[7] * bt}; } } }
        __syncthreads();
        if (wave < 6) { const bool isL = wave < 3; const int j = isL ? wave : wave - 3; const int ab = isL ? (j >= 1) : (j == 2), bb = isL ? (j == 2) : (j >= 1);
            const int arow = 32 * ab + r32, brow = 32 * bb + r32; const LAS unsigned char* At = L + L_KN; const LAS unsigned char* Bt = L + (isL ? L_KN : L_QN);
            f32x16 acc = {};
#pragma unroll
            for (int s = 0; s < 8; ++s) { const bf16x8 a = *(const LAS bf16x8*)(At + sw256(arow, 2 * s + hi)), bq = *(const LAS bf16x8*)(Bt + sw256(brow, 2 * s + hi)); acc = __builtin_amdgcn_mfma_f32_32x32x16_bf16(a, bq, acc, 0, 0, 0); }
            if (isL) { const int m = brow; const float gm = GC[m];
#pragma unroll
                for (int r = 0; r < 16; ++r) { const int c = 32 * ab + crow(r, hi); const float d = fminf(GC[c] - gm, 0.f); LM[c * 64 + m] = (c > m) ? acc[r] * GC[192 + c] * __expf(d) : 0.f; } }
            else { const int c = brow; const float gcc = GC[c];
#pragma unroll
                for (int g4 = 0; g4 < 4; ++g4) { float v[4];
#pragma unroll
                    for (int e = 0; e < 4; ++e) { const int m = 32 * ab + 8 * g4 + 4 * hi + e; const float d = fminf(gcc - GC[m], 0.f); v[e] = (c >= m) ? acc[4 * g4 + e] * __expf(d) : 0.f; }
                    v2u w = {pk2r(v[0], v[1]), pk2r(v[2], v[3])}; *(LAS v2u*)(L + L_AT + at_off(j, r32, g4) + 8 * hi) = w; } } }
        __syncthreads();
        if (wave < 4) { LAS float* R = (wave < 2) ? RV : RK; const int col = 64 * (wave & 1) + lv; float x[64];
#pragma unroll
            for (int c = 0; c < 64; ++c) x[c] = R[c * 128 + col];
            int lmb = L_LM + (lv & 0); asm volatile("" : "+v"(lmb));
            f32x4 lbuf[SOLVE_RING];
            solve_pro(lbuf, L + lmb, std::make_integer_sequence<int, SOLVE_PF>{});
            solve_all(x, lbuf, L + lmb, std::make_integer_sequence<int, SOLVE_NGRP>{});
            if (wave < 2) {
#pragma unroll
                for (int c = 0; c < 64; ++c) R[c * 128 + col] = x[c]; }
            else {
#pragma unroll
                for (int c = 0; c < 64; ++c) *(LAS bf16*)(L + L_KN + sw256(c, col >> 3) + (col & 7) * 2) = (bf16)(pk2r(-x[c], 0.f) & 0xffffu); } }
        __syncthreads();
        { const int tid = wave * 64 + lv; const size_t foot = (grow0 * 1024 + (size_t)h * 128);
#pragma unroll
            for (int i = 0; i < 2; ++i) { const int p = tid + 512 * i; const size_t go = foot + (size_t)(p >> 4) * 1024 + (p & 15) * 8;
                *(GAS v4u*)(OA + go) = *(const LAS v4u*)(L + L_KN + 16 * p); *(GAS v4u*)(QA + go) = *(const LAS v4u*)(L + L_QD + 16 * p); *(GAS v4u*)(KA + go) = *(const LAS v4u*)(L + L_KDT + 16 * p);
                const f32x4 u0 = *(const LAS f32x4*)(RV + 8 * p), u1 = *(const LAS f32x4*)(RV + 8 * p + 4); v4u uw = {pk2r(u0[0], u0[1]), pk2r(u0[2], u0[3]), pk2r(u1[0], u1[1]), pk2r(u1[2], u1[3])}; *(GAS v4u*)(VA + go) = uw; }
            if (tid < 384) *(GAS v4u*)(ws + WS_ATG + (size_t)((b * 8 + h) * 64 + ch) * 6144 + 16 * tid) = *(const LAS v4u*)(L + L_AT + 16 * tid);
            if (tid == 0) ((float*)(ws + WS_GLAST))[(b * 8 + h) * 64 + ch] = __expf(GC[63]); }
        __syncthreads();
    }
}

__device__ __forceinline__ void scan_load(v4u (&pre)[9], float& gl, const unsigned char* ws, const float* dout, int b, int h, int ch, int tid) {
    const bf16* QA = (const bf16*)dout; const bf16* KA = (const bf16*)dout + (size_t)TOK * 1024; const bf16* VA = (const bf16*)(ws + WS_VA); const bf16* OA = (const bf16*)(ws + WS_OA);
    const size_t foot = (((size_t)b * SEQL + ch * 64) * 1024 + (size_t)h * 128);
#pragma unroll
    for (int i = 0; i < 2; ++i) { const int p = tid + 512 * i; const size_t go = foot + (size_t)(p >> 4) * 1024 + (p & 15) * 8;
        pre[i] = *(const GAS v4u*)(OA + go); pre[2 + i] = *(const GAS v4u*)(QA + go); pre[4 + i] = *(const GAS v4u*)(KA + go); pre[6 + i] = *(const GAS v4u*)(VA + go); }
    pre[8] = (v4u){0u, 0u, 0u, 0u}; if (tid < 384) pre[8] = *(const GAS v4u*)(ws + WS_ATG + (size_t)((b * 8 + h) * 64 + ch) * 6144 + 16 * tid);
    gl = ((const float*)(ws + WS_GLAST))[(b * 8 + h) * 64 + ch];
}
__device__ __forceinline__ void scan_store(const v4u (&pre)[9], float gl, LAS unsigned char* IB, LAS unsigned char* L, int slot, int tid) {
#pragma unroll
    for (int i = 0; i < 2; ++i) { const int p = tid + 512 * i;
        *(LAS v4u*)(IB + IMG_W + 16 * p) = pre[i]; *(LAS v4u*)(IB + IMG_QD + 16 * p) = pre[2 + i]; *(LAS v4u*)(IB + IMG_KDT + 16 * p) = pre[4 + i]; *(LAS v4u*)(IB + IMG_U + 16 * p) = pre[6 + i]; }
    if (tid < 384) *(LAS v4u*)(IB + IMG_AT + 16 * tid) = pre[8];
    if (tid == 0) *(LAS float*)(L + SC_GL + slot * 4) = gl;
}
__device__ __forceinline__ void scan_block(Frame& F, unsigned char* ws, float* dout, int b, int h) {
    LAS unsigned char* L = F.lds; const int wave = F.wave;
    bf16* OA = (bf16*)(ws + WS_OA);
    f32x16 S[4];
#pragma unroll
    for (int i = 0; i < 4; ++i) S[i] = (f32x16){};
    v4u pre[9]; float gl;
    { const int tid0 = wave * 64 + lane_id(); scan_load(pre, gl, ws, dout, b, h, 0, tid0); scan_store(pre, gl, L, L, 0, tid0); }
    __syncthreads();
    for (int ch = 0; ch < SEQL / 64; ++ch) {
        const size_t grow0 = (size_t)b * SEQL + ch * 64;
        int lv = lane_id(); asm volatile("" : "+v"(lv));
        const int hi = lv >> 5, r32 = lv & 31, l = lv, tid = wave * 64 + lv;
        LAS unsigned char* IB = L + (ch & 1) * IMG_BYTES;
        if (ch + 1 < SEQL / 64) scan_load(pre, gl, ws, dout, b, h, ch + 1, tid);
        if (wave < 4) { const int dvb = wave; const float eg = *(const LAS float*)(L + SC_GL + (ch & 1) * 4);
            f32x16 av[2], ao[2];
#pragma unroll
            for (int cb = 0; cb < 2; ++cb) { ao[cb] = (f32x16){};
#pragma unroll
                for (int r = 0; r < 16; ++r) av[cb][r] = __uint_as_float((unsigned)(*(const LAS bf16*)(IB + IMG_U + ((32 * cb + crow(r, hi)) * 128 + 32 * dvb + r32) * 2)) << 16); }
#pragma unroll
            for (int d = 0; d < 4; ++d)
#pragma unroll
                for (int s = 0; s < 2; ++s) { const bf16x8 sbf = packacc(S[d], s); const int c0 = 4 * d + 2 * s;
#pragma unroll
                    for (int cb = 0; cb < 2; ++cb) { const int row = 32 * cb + r32;
                        av[cb] = __builtin_amdgcn_mfma_f32_32x32x16_bf16(frag2(IB + IMG_W, sw256(row, c0) + 8 * hi, sw256(row, c0 + 1) + 8 * hi), sbf, av[cb], 0, 0, 0);
                        ao[cb] = __builtin_amdgcn_mfma_f32_32x32x16_bf16(frag2(IB + IMG_QD, sw256(row, c0) + 8 * hi, sw256(row, c0 + 1) + 8 * hi), sbf, ao[cb], 0, 0, 0); } }
            bf16x8 vb[2][2];
#pragma unroll
            for (int mb = 0; mb < 2; ++mb) { vb[mb][0] = packacc(av[mb], 0); vb[mb][1] = packacc(av[mb], 1); }
#pragma unroll
            for (int cb = 0; cb < 2; ++cb) { const int row = 32 * cb + r32;
#pragma unroll
                for (int mb = 0; mb <= cb; ++mb)
#pragma unroll
                    for (int s = 0; s < 2; ++s) { const int bi = cb + mb; ao[cb] = __builtin_amdgcn_mfma_f32_32x32x16_bf16(frag2(IB + IMG_AT, at_off(bi, r32, 2 * s) + 8 * hi, at_off(bi, r32, 2 * s + 1) + 8 * hi), vb[mb][s], ao[cb], 0, 0, 0); } }
#pragma unroll
            for (int d = 0; d < 4; ++d) { const int row = 32 * d + r32; S[d] = S[d] * eg;
#pragma unroll
                for (int mb = 0; mb < 2; ++mb)
#pragma unroll
                    for (int s = 0; s < 2; ++s) { const int c0 = 4 * mb + 2 * s; S[d] = __builtin_amdgcn_mfma_f32_32x32x16_bf16(frag2(IB + IMG_KDT, sw128(row, c0) + 8 * hi, sw128(row, c0 + 1) + 8 * hi), vb[mb][s], S[d], 0, 0, 0); } }
#pragma unroll
            for (int cb = 0; cb < 2; ++cb)
#pragma unroll
                for (int r = 0; r < 16; ++r) *(LAS bf16*)(L + SC_O + ((32 * cb + crow(r, hi)) * 128 + 32 * dvb + r32) * 2) = (bf16)(pk2r(ao[cb][r], 0.f) & 0xffffu); }
        asm volatile("s_waitcnt lgkmcnt(0)" ::: "memory"); __builtin_amdgcn_s_barrier(); asm volatile("" ::: "memory");
#pragma unroll
        for (int i = 0; i < 8; ++i) { const int c = 8 * wave + i; const unsigned ow = *(const LAS unsigned*)(L + SC_O + (c * 128 + 2 * l) * 2); const float a = __uint_as_float(ow << 16), bq = __uint_as_float(ow & 0xffff0000u); const float ss = wave_sum(a * a + bq * bq); const float rs = 1.0f / sqrtf(ss * (1.0f / 128.0f) + 1e-6f);
            *(GAS unsigned*)(OA + (grow0 + c) * 1024 + h * 128 + 2 * l) = pk2r(a * rs, bq * rs); }
        if (ch + 1 < SEQL / 64) scan_store(pre, gl, L + ((ch + 1) & 1) * IMG_BYTES, L, (ch + 1) & 1, tid);
        asm volatile("s_waitcnt lgkmcnt(0)" ::: "memory"); __builtin_amdgcn_s_barrier(); asm volatile("" ::: "memory");
    }
}
}
namespace xat {
constexpr int L_KC = 0, L_VT = 65536, L_WS = 131072, L_BYTES = 131072 + 8 * 256;
__device__ __forceinline__ int swVT(int row, int chunk) { return row * 512 + ((chunk ^ (row & 31)) << 4); }
__device__ __forceinline__ void unit(Frame& F, unsigned char* ws, int pm, int hd) {
    LAS unsigned char* L = F.lds; const int wave = F.wave, l = lane_id(), tid = wave * 64 + l, hi = l >> 5, r32 = l & 31;
    const bf16* QC = (const bf16*)(ws + WS_QC); const bf16* KVC = (const bf16*)(ws + WS_KVC); bf16* OC = (bf16*)(ws + WS_OC);
    const int b = pm >> 4; const size_t row0 = (size_t)pm * 256 + wave * 32;
#pragma unroll
    for (int i = 0; i < 8; ++i) { const int id = tid + 512 * i, key = id >> 4, ch = id & 15; const bf16* kp = KVC + (size_t)(b * 256 + key) * 1024 + hd * 128 + 8 * ch;
        *(LAS v4u*)(L + L_KC + gdn::sw256(key, ch)) = *(const GAS v4u*)kp;
        const v4u vv = *(const GAS v4u*)(kp + 512);
#pragma unroll
        for (int e = 0; e < 4; ++e) { const unsigned w = vv[e]; const int dv = 8 * ch + 2 * e;
            *(LAS bf16*)(L + L_VT + swVT(dv, key >> 3) + (key & 7) * 2) = (bf16)(w & 0xffffu); *(LAS bf16*)(L + L_VT + swVT(dv + 1, key >> 3) + (key & 7) * 2) = (bf16)(w >> 16); } }
    bf16x8 qr[8];
#pragma unroll
    for (int s = 0; s < 8; ++s) qr[s] = *(const GAS bf16x8*)(QC + (row0 + r32) * 512 + hd * 128 + 16 * s + 8 * hi);
    __syncthreads();
    LAS float* wsf = (LAS float*)(L + L_WS + wave * 256);
    f32x16 O[4];
#pragma unroll
    for (int d = 0; d < 4; ++d) O[d] = (f32x16){};
    float mrun = -1e30f, lrun = 0.f;
    for (int kt = 0; kt < 4; ++kt) {
        f32x16 p[2];
#pragma unroll
        for (int j = 0; j < 2; ++j) { p[j] = (f32x16){}; const int key = 64 * kt + 32 * j + r32;
#pragma unroll
            for (int s = 0; s < 8; ++s) p[j] = __builtin_amdgcn_mfma_f32_32x32x16_bf16(*(const LAS bf16x8*)(L + L_KC + gdn::sw256(key, 2 * s + hi)), qr[s], p[j], 0, 0, 0); }
        float tm = p[0][0];
#pragma unroll
        for (int r = 0; r < 16; ++r) tm = fmaxf(tm, fmaxf(p[0][r], p[1][r]));
        tm = fmaxf(tm, __shfl_xor(tm, 32));
        const float mn = fmaxf(mrun, tm), alpha = __builtin_amdgcn_exp2f(mrun - mn); mrun = mn;
        float ls = 0.f;
#pragma unroll
        for (int j = 0; j < 2; ++j)
#pragma unroll
            for (int r = 0; r < 16; ++r) { p[j][r] = __builtin_amdgcn_exp2f(p[j][r] - mn); ls += p[j][r]; }
        lrun = lrun * alpha + ls;
        if (hi == 0) wsf[r32] = alpha;
        LDS_WAIT(); asm volatile("" ::: "memory");
#pragma unroll
        for (int r = 0; r < 16; ++r) { const float a = wsf[gdn::crow(r, hi)];
#pragma unroll
            for (int d = 0; d < 4; ++d) O[d][r] *= a; }
#pragma unroll
        for (int j = 0; j < 2; ++j)
#pragma unroll
            for (int s = 0; s < 2; ++s) { const bf16x8 af = gdn::packacc(p[j], s); const int c0 = 8 * kt + 4 * j + 2 * s;
#pragma unroll
                for (int d = 0; d < 4; ++d) { const int dv = 32 * d + r32; O[d] = __builtin_amdgcn_mfma_f32_32x32x16_bf16(af, gdn::frag2(L + L_VT, swVT(dv, c0) + 8 * hi, swVT(dv, c0 + 1) + 8 * hi), O[d], 0, 0, 0); } }
        LDS_WAIT(); asm volatile("" ::: "memory");
    }
    lrun += __shfl_xor(lrun, 32);
    if (hi == 0) wsf[32 + r32] = 1.0f / lrun;
    LDS_WAIT(); asm volatile("" ::: "memory");
#pragma unroll
    for (int r = 0; r < 16; ++r) { const int q = gdn::crow(r, hi); const float il = wsf[32 + q];
#pragma unroll
        for (int d = 0; d < 4; ++d) OC[(row0 + q) * 512 + hd * 128 + 32 * d + r32] = (bf16)(pk2r(O[d][r] * il, 0.f) & 0xffffu); }
    __syncthreads();
}
}
#ifndef USE_CG
#define USE_CG 0
#endif
#ifndef PH_LAST
#define PH_LAST 99
#endif
#ifndef TPROBE_W
#define TPROBE_W 4
#endif
__global__ void __launch_bounds__(NWAVES * 64, 2) fwd_megakernel(Args args) {
    extern __shared__ __attribute__((aligned(16))) unsigned char lds[];
    Frame F;
    F.lds = (LAS unsigned char*)lds; F.MISC = (volatile LAS unsigned*)(F.lds + MISC_OFF);
    F.wave = __builtin_amdgcn_readfirstlane((int)threadIdx.x >> 6);
    const bool t0 = (threadIdx.x == 0);
    F.G = gridDim.x; { const int bx = blockIdx.x; F.vcu = (F.G % 8 == 0) ? (bx % 8) * (F.G / 8) + bx / 8 : bx; }
    unsigned char* ws = args.ws; float* dout = args.out;
    F.ctl = (gu32*)(ws + WS_CTL);
    for (int u = F.wave * 64 + lane_id(); u < (LDS_BYTES - LDSCTL_OFF) / 4; u += NWAVES * 64) ((LAS unsigned*)(F.lds + LDSCTL_OFF))[u] = 0u;
    __syncthreads();
#if USE_CG
    cg::grid_group grid = cg::this_grid();
#define GRID_BAR() grid.sync()
#else
    XcdBarrier bar = xcd_barrier_post((unsigned*)(F.ctl + CW_BAR), F.MISC + 8, t0);
#define GRID_BAR() xcd_barrier(bar, F.wave == 0 && lane_id() == 0)
#endif
    const int c = (int)blockIdx.x, G = F.G;
    int n_stamp = 0; unsigned long long* const tsb = (unsigned long long*)(ws + WS_CTL) + 6144;
#define STAMP() do { if (TPROBE >= 0) { if (c == 0 && F.wave == 0 && lane_id() == 0) tsb[n_stamp] = rt(); ++n_stamp; } } while (0)
    STAMP();
    constexpr int NOSPLIT = 1 << 30;
    LAS unsigned char* ring = F.lds;

    p0_prologue(F, args, ws);
    GRID_BAR(); STAMP();
#if PH_LAST >= 1
    for (int mu = c; mu < TOK / 64; mu += G) ab_unit(F, args, ws, mu);
    {   pg8::Gemm g{(const pg8::bf16_t*)(ws + WS_XB), (const pg8::bf16_t*)(ws + WS_W1), TOK, 6144, 1024, NOSPLIT, 0L}; pg8::StaticOrder S; S.init(TOK, 6144, G, c);
        pg8::EpiP1 E{(pg8::bf16_t*)dout, (pg8::bf16_t*)dout + (size_t)TOK * 1024, (pg8::bf16_t*)(ws + WS_VA), (pg8::bf16_t*)(ws + WS_QB), (pg8::bf16_t*)(ws + WS_KB), (pg8::bf16_t*)(ws + WS_VB),
                     (const float*)(ws + WS_RSTD0), (const float*)(ws + WS_RCOS), (const float*)(ws + WS_RSIN), C2Q, (pg8::bf16_t*)(ws + gdn::WS_HALO)};
        pg8::gemm_phase<pg8::EpiP1, pg8::StaticOrder, true, true>(ring, g, S, E, F.wave); }
    GRID_BAR(); STAMP();
#endif
#if PH_LAST >= 2
    for (int u = c; u < NBATCH * 8 * (SEQL / 64); u += G) gdn::prep_unit(F, args, ws, dout, u >> 9, (u >> 6) & 7, u & 63);
    GRID_BAR(); STAMP();
    {
#ifndef NO_GDN
        if (c < 32) gdn::scan_block(F, ws, dout, c >> 3, c & 7);
#endif
        float s1 = 0.f, s2 = 0.f; { const float* q1 = (const float*)args.in[9]; const float* k1 = (const float*)args.in[10]; const float* q2 = (const float*)args.in[11]; const float* k2 = (const float*)args.in[12];
            for (int i = 0; i < 64; ++i) { s1 += q1[i] * k1[i]; s2 += q2[i] * k2[i]; } }
        const float lam = __uint_as_float((unsigned)__builtin_amdgcn_readfirstlane((int)__float_as_uint(expf(s1) - expf(s2) + 0.2f)));
        const attn_body::bf16* QBp = (const attn_body::bf16*)(ws + WS_QB); const attn_body::bf16* KBp = (const attn_body::bf16*)(ws + WS_KB); const attn_body::bf16* VBp = (const attn_body::bf16*)(ws + WS_VB);
#ifndef NO_ATTN
        for (;;) {
            int moff = MISC_OFF + 64; asm volatile("" : "+v"(moff));
            volatile LAS unsigned* qw = (volatile LAS unsigned*)(F.lds + moff);
            if (F.wave == 0 && lane_id() == 0) *qw = __hip_atomic_fetch_add((unsigned*)(F.ctl + CW_QUEUE), 1u, __ATOMIC_RELAXED, __HIP_MEMORY_SCOPE_AGENT);
            __syncthreads(); const unsigned idx = (unsigned)__builtin_amdgcn_readfirstlane((int)*qw); __syncthreads();
            if (idx >= 512u) break;
            const int b = (idx & 31) >> 3, h = idx & 7, qb = 15 - (int)(idx >> 5);
            for (int mode = 0; mode < 4; ++mode)
                attn_body::attn_unit<8>(b, (2 * h + (mode & 1)) * 64, h * 128 + (mode >> 1) * 64, h * 128, qb, mode, lam, QBp, KBp, VBp, (attn_body::bf16*)(ws + WS_QB), (char*)lds, F.wave);
        }
#endif
        (void)lam; (void)QBp; (void)KBp; (void)VBp; }
    GRID_BAR(); STAMP();
#endif
#if PH_LAST >= 3
    {   pg8::Gemm g{(const pg8::bf16_t*)(ws + WS_XB), (const pg8::bf16_t*)(ws + WS_WGZ), TOK, 3072, 1024, NOSPLIT, 0L}; pg8::StaticOrder S; S.init(TOK, 3072, G, c);
        pg8::EpiP3a E{(pg8::bf16_t*)dout, (pg8::bf16_t*)(ws + WS_OA), (const float*)(ws + WS_RSTD0)};
        pg8::gemm_phase<pg8::EpiP3a, pg8::StaticOrder, true, true>(ring, g, S, E, F.wave); }
    GRID_BAR(); STAMP();
    {   pg8::Gemm g{(const pg8::bf16_t*)(ws + WS_OA), (const pg8::bf16_t*)(ws + WS_WOUTA), TOK, 2048, 1024, 4, (long)WS_QB - (long)WS_OA}; pg8::PairOrder S; S.init(TOK, G, c);
        pg8::EpiP3b E{(const pg8::bf16_t*)dout, (pg8::bf16_t*)(ws + WS_MERGED)};
        pg8::gemm_phase<pg8::EpiP3b, pg8::PairOrder, true, true>(ring, g, S, E, F.wave); }
    GRID_BAR(); STAMP();
#endif
#if PH_LAST >= 4
    {   pg8::Gemm g{(const pg8::bf16_t*)(ws + WS_MERGED), (const pg8::bf16_t*)(ws + WS_WO), TOK, 1024, 1024, NOSPLIT, 0L}; pg8::StaticOrder S; S.init(TOK, 1024, G, c);
        pg8::EpiRes E{(const float*)args.in[0], (float*)(ws + WS_X1), (pg8::bf16_t*)(ws + WS_X1B), (float*)(ws + WS_SS1)};
        pg8::gemm_phase<pg8::EpiRes, pg8::StaticOrder, true, true>(ring, g, S, E, F.wave); }
    GRID_BAR(); STAMP();
#endif
#if PH_LAST >= 5
    {   pg8::Gemm g{(const pg8::bf16_t*)(ws + WS_X1B), (const pg8::bf16_t*)(ws + WS_WCQ), TOK, 512, 1024, NOSPLIT, 0L}; pg8::StaticOrder S; S.init(TOK, 512, G, c);
        pg8::EpiRowBf16 E{(pg8::bf16_t*)(ws + WS_QC), 512, nullptr, (const float*)(ws + WS_SS1)};
        pg8::gemm_phase<pg8::EpiRowBf16, pg8::StaticOrder, true, true>(ring, g, S, E, F.wave); }
    {   pg8::Gemm g{(const pg8::bf16_t*)(ws + WS_MEMB), (const pg8::bf16_t*)(ws + WS_WCKV), MEMT, 1024, 1024, NOSPLIT, 0L}; pg8::StaticOrder S; S.init(MEMT, 1024, G, (c + G - (128 % G)) % G);
        pg8::EpiRowBf16 E{(pg8::bf16_t*)(ws + WS_KVC), 1024, (const float*)(ws + WS_RSTDM), nullptr};
        pg8::gemm_phase<pg8::EpiRowBf16, pg8::StaticOrder, true, true>(ring, g, S, E, F.wave); }
    GRID_BAR(); STAMP();
    for (int u = c; u < (TOK / 256) * 4; u += G) xat::unit(F, ws, u >> 2, u & 3);
    GRID_BAR(); STAMP();
#endif
#if PH_LAST >= 6
    {   pg8::Gemm g{(const pg8::bf16_t*)(ws + WS_OC), (const pg8::bf16_t*)(ws + WS_WCO), TOK, 1024, 512, NOSPLIT, 0L}; pg8::StaticOrder S; S.init(TOK, 1024, G, c);
        pg8::EpiRes E{(const float*)(ws + WS_X1), dout, (pg8::bf16_t*)(ws + WS_XB), (float*)(ws + WS_SS2)};
        pg8::gemm_phase<pg8::EpiRes, pg8::StaticOrder, true, true>(ring, g, S, E, F.wave); }
    GRID_BAR(); STAMP();
#endif
#if PH_LAST >= 7
    {   pg8::Gemm g{(const pg8::bf16_t*)(ws + WS_XB), (const pg8::bf16_t*)(ws + WS_WFFI), TOK, 2 * DFF, 1024, NOSPLIT, 0L}; pg8::StaticOrder S; S.init(TOK, 2 * DFF, G, c);
        pg8::EpiAct E{(pg8::bf16_t*)(ws + WS_ACT), (const float*)(ws + WS_SS2)};
        pg8::gemm_phase<pg8::EpiAct, pg8::StaticOrder, true, true>(ring, g, S, E, F.wave); }
    GRID_BAR(); STAMP();
#endif
#if PH_LAST >= 8
    {   pg8::Gemm g{(const pg8::bf16_t*)(ws + WS_ACT), (const pg8::bf16_t*)(ws + WS_WFFO), TOK, 1024, DFF, NOSPLIT, 0L}; pg8::StaticOrder S; S.init(TOK, 1024, G, c);
        pg8::EpiRes E{dout, dout, nullptr, (float*)(ws + WS_SS3)};
        pg8::gemm_phase<pg8::EpiRes, pg8::StaticOrder, true, true>(ring, g, S, E, F.wave); }
    GRID_BAR(); STAMP();
    final_rows(F, dout, (const float*)(ws + WS_SS3), (const float*)args.in[26]);
#endif
    STAMP();
    if (TPROBE >= 0 && c == 0 && F.wave == 0 && lane_id() == 0) { asm volatile("s_waitcnt vmcnt(0)" ::: "memory"); const unsigned long long t0_ = (TPROBE >= 100) ? 0ull : __hip_atomic_load(tsb + (TPROBE % 100), __ATOMIC_RELAXED, __HIP_MEMORY_SCOPE_AGENT), t1_ = (TPROBE >= 100) ? __hip_atomic_load(tsb + 16 + (TPROBE % 100), __ATOMIC_RELAXED, __HIP_MEMORY_SCOPE_AGENT) : __hip_atomic_load(tsb + (TPROBE % 100) + 1, __ATOMIC_RELAXED, __HIP_MEMORY_SCOPE_AGENT);
        const unsigned long long te_ = rt(), dl_ = (t1_ - t0_) * (unsigned long long)TPROBE_W; while (rt() - te_ < dl_) __builtin_amdgcn_s_sleep(32); }
}

extern "C" void kernel_launch(void* const* d_in, const int* in_sizes, int n_in, void* d_out, int out_size, void* d_ws, size_t ws_size, hipStream_t stream) {
    static int grid = 0;
    if (grid == 0) {
        if (n_in != 27 || out_size != TOK * DMODEL || ws_size < WS_END) { fprintf(stderr, "kernel_launch: unexpected problem shape (n_in %d, out %d, ws %zu); nothing launched\n", n_in, out_size, ws_size); grid = -1; return; }
        int dev = 0, cus = 0, per_cu = 0;
        if (hipGetDevice(&dev) != hipSuccess || hipDeviceGetAttribute(&cus, hipDeviceAttributeMultiprocessorCount, dev) != hipSuccess) { grid = -1; return; }
        if (hipFuncSetAttribute((const void*)fwd_megakernel, hipFuncAttributeMaxDynamicSharedMemorySize, LDS_BYTES) != hipSuccess) { fprintf(stderr, "kernel_launch: hipFuncSetAttribute failed\n"); grid = -1; return; }
        if (hipOccupancyMaxActiveBlocksPerMultiprocessor(&per_cu, (const void*)fwd_megakernel, NWAVES * 64, LDS_BYTES) != hipSuccess || per_cu < 1) { fprintf(stderr, "kernel_launch: occupancy query reports %d workgroups per CU\n", per_cu); per_cu = 1; }
        (void)hipGetLastError();
        grid = cus;
        if (grid != 256) fprintf(stderr, "kernel_launch: %d CUs (tuned for 256)\n", grid);
    }
    if (grid < 0) return;
    (void)hipMemsetAsync((char*)d_ws + WS_CTL, 0, CTL_ZERO_BYTES, stream);
    Args a{};
    for (int i = 0; i < 27; ++i) a.in[i] = d_in[i];
    a.out = (float*)d_out; a.ws = (unsigned char*)d_ws;
    for (int i = 0; i < 8; ++i) a.invf[i] = powf(500000.0f, -(float)(2 * i) / 16.0f);
    void* kargs[] = {&a};
    const hipError_t e = hipLaunchCooperativeKernel((const void*)fwd_megakernel, dim3(grid), dim3(NWAVES * 64), kargs, LDS_BYTES, stream);
    if (e != hipSuccess) fprintf(stderr, "kernel_launch: cooperative launch failed: %s (grid %d)\n", hipGetErrorString(e), grid);
}
```

```cpp
#include <hip/hip_runtime.h>
#include <hip/hip_bf16.h>
#include <hip/hip_cooperative_groups.h>
#include <cstdio>
#include <cstdint>
#include <cmath>
#include <utility>
namespace cg = cooperative_groups;
#ifndef TPROBE
#define TPROBE -1
#endif
#ifndef DBG
#define DBG 0
#endif
__device__ __forceinline__ int lane_id() { int x; asm volatile("v_mbcnt_lo_u32_b32 %0, -1, 0\n\tv_mbcnt_hi_u32_b32 %0, -1, %0" : "=v"(x)); return x; }
__device__ __forceinline__ int fresh_s(int v) { asm volatile("" : "+s"(v)); return v; }
namespace pg8 {
#define PG8_LAS __attribute__((address_space(3)))
typedef unsigned short bf16_t;
typedef short bf16x8 __attribute__((ext_vector_type(8)));
typedef float f32x4 __attribute__((ext_vector_type(4)));
typedef unsigned u32x4 __attribute__((ext_vector_type(4)));
constexpr int BM = 256, BK = 64, HALF = 128, HTB = HALF * BK * 2  , STAGE_BYTES = 8 * HTB, NXCD = 8, WGM = 8;

__host__ __device__ __forceinline__ int lds_byte(int r, int c) { const int st = (r >> 4) * 2 + (c >> 5), rr = r & 15, cc = c & 31, ob = rr * 64 + cc * 2; return st * 1024 + (ob ^ (((ob >> 9) & 1) << 5)); }
__host__ __device__ __forceinline__ void stage_rc(int b, int& R, int& C) { const int st = b / 1024, sb = b % 1024, swz = sb ^ (((sb >> 9) & 1) << 5); R = (st >> 1) * 16 + swz / 64; C = (st & 1) * 32 + (swz % 64) / 2; }
__host__ __device__ __forceinline__ int perm32(int rho) { const int n = rho >> 4, i = rho & 15; return 8 * (i >> 2) + 4 * n + (i & 3); }

struct Unit { int pm, pn; };
struct Gemm { const bf16_t* A; const bf16_t* Bt; int M, N, K; int a_split; long a_delta; };

struct StaticOrder {
    int nM, nN, nwg, G, c;
    __host__ __device__ void init(int M, int N, int G_, int c_) { nM = M / BM; nN = N / BM; nwg = nM * nN; G = G_; c = c_; }
    __host__ __device__ bool next(int i, Unit& u) const {
        const long L = (long)i * G + c; if (L >= nwg) return false;
        int wgid = (int)L; { const int q = nwg / NXCD, r = nwg % NXCD, xcd = wgid % NXCD, off = wgid / NXCD; wgid = (xcd < r ? xcd * (q + 1) : r * (q + 1) + (xcd - r) * q) + off; }
        const int nig = WGM * nN, gid = wgid / nig, fm = gid * WGM, gsz = (nM - fm) < WGM ? (nM - fm) : WGM;
        u.pm = fm + ((wgid % nig) % gsz); u.pn = (wgid % nig) / gsz; return true;
    }
    __device__ __forceinline__ void a_ready(const Unit&) const {}
    __device__ __forceinline__ void done(const Unit&) const {}
};

__device__ __forceinline__ unsigned cvt_pk_bf16(float lo, float hi) { unsigned r; asm volatile("v_cvt_pk_bf16_f32 %0, %1, %2" : "=v"(r) : "v"(lo), "v"(hi)); return r; }
typedef float f32x2 __attribute__((ext_vector_type(2)));
typedef float f32x2 __attribute__((ext_vector_type(2)));
typedef unsigned u32x2 __attribute__((ext_vector_type(2)));
__device__ __forceinline__ u32x4 pk8(const f32x4 a, const f32x4 b) { u32x4 w; w.x = cvt_pk_bf16(a[0], a[1]); w.y = cvt_pk_bf16(a[2], a[3]); w.z = cvt_pk_bf16(b[0], b[1]); w.w = cvt_pk_bf16(b[2], b[3]); return w; }
__device__ __forceinline__ float bflo(unsigned u) { return __uint_as_float(u << 16); }
__device__ __forceinline__ float bfhi(unsigned u) { return __uint_as_float(u & 0xffff0000u); }
__device__ __forceinline__ float sigmoidf_(float x) { return __builtin_amdgcn_rcpf(1.0f + __builtin_amdgcn_exp2f(-1.4426950408889634f * x)); }
__device__ __forceinline__ float rstd16(const float* ss16) { const f32x4 a = *(const f32x4*)ss16, b = *(const f32x4*)(ss16 + 4), c = *(const f32x4*)(ss16 + 8), d = *(const f32x4*)(ss16 + 12);
    const float s = ((a[0] + a[1]) + (a[2] + a[3])) + ((b[0] + b[1]) + (b[2] + b[3])) + ((c[0] + c[1]) + (c[2] + c[3])) + ((d[0] + d[1]) + (d[2] + d[3])); return __builtin_amdgcn_rsqf(s * (1.0f / 1024.0f) + 1e-6f); }

struct EpiP1 {
    static constexpr bool PERM = true, AFTER_DRAIN = false;
    bf16_t *d0, *d1, *d2, *d3, *d4, *d5; const float* rstd; const float* rcos; const float* rsin; float qscale; bf16_t* halo;
    __device__ __forceinline__ void operator()(const f32x4 (&acc)[2][2][4][2], const Unit& u, int wr, int wc, int fr, int fq) const {
        const int grp = u.pn >> 2; bf16_t* base = grp == 0 ? d0 : grp == 1 ? d1 : grp == 2 ? d2 : grp == 3 ? d3 : grp == 4 ? d4 : d5; const int col0 = (u.pn & 3) * BM + wc * 32 + 8 * fq;
        const bool rope = (grp == 3 || grp == 4) && ((wc & 1) == 0); const float sc = (grp == 3) ? qscale : 1.0f;
#pragma unroll
        for (int ai = 0; ai < 2; ++ai)
#pragma unroll
            for (int m = 0; m < 4; ++m) { const int row = u.pm * BM + ai * HALF + wr * 64 + m * 16 + fr; const float rs = rstd[row] * sc;
                f32x4 c0 = {1.f, 1.f, 1.f, 1.f}, c1 = c0, s0 = {0.f, 0.f, 0.f, 0.f}, s1 = s0;
                if (rope) { c0 = *(const f32x4*)(rcos + (size_t)row * 8); c1 = *(const f32x4*)(rcos + (size_t)row * 8 + 4); s0 = *(const f32x4*)(rsin + (size_t)row * 8); s1 = *(const f32x4*)(rsin + (size_t)row * 8 + 4);
                    if (fq >= 2) { c0 = (f32x4){1.f, 1.f, 1.f, 1.f}; c1 = c0; s0 = (f32x4){0.f, 0.f, 0.f, 0.f}; s1 = s0; } else if (fq == 0) { s0 = -s0; s1 = -s1; } }
#pragma unroll
                for (int bj = 0; bj < 2; ++bj) { f32x4 v0 = acc[ai][bj][m][0] * rs, v1 = acc[ai][bj][m][1] * rs;
                    if (rope) { f32x4 p0, p1;
#pragma unroll
                        for (int e = 0; e < 4; ++e) { p0[e] = __shfl_xor(v0[e], 16); p1[e] = __shfl_xor(v1[e], 16); }
                        v0 = v0 * c0 + p0 * s0; v1 = v1 * c1 + p1 * s1; }
                    const u32x4 pw = pk8(v0, v1); *(u32x4*)(base + (size_t)row * 1024 + col0 + bj * HALF) = pw;
                    if (m == 3 && grp < 3 && fr >= 13) *(u32x4*)(halo + ((size_t)(row >> 6) * 3 + (fr - 13)) * 3072 + grp * 1024 + col0 + bj * HALF) = pw; } }
    }
};
struct EpiP3a {
    static constexpr bool PERM = true, AFTER_DRAIN = false;
    bf16_t* gates; bf16_t* oa; const float* rstd;
    __device__ __forceinline__ void operator()(const f32x4 (&acc)[2][2][4][2], const Unit& u, int wr, int wc, int fr, int fq) const {
        const bool isg = u.pn < 8; const int col0 = (isg ? u.pn * BM : (u.pn - 8) * BM) + wc * 32 + 8 * fq;
        if (isg) {
#pragma unroll
            for (int ai = 0; ai < 2; ++ai)
#pragma unroll
                for (int m = 0; m < 4; ++m) { const int row = u.pm * BM + ai * HALF + wr * 64 + m * 16 + fr; const float rs = rstd[row];
#pragma unroll
                    for (int bj = 0; bj < 2; ++bj) { f32x4 v0 = acc[ai][bj][m][0] * rs, v1 = acc[ai][bj][m][1] * rs;
#pragma unroll
                        for (int e = 0; e < 4; ++e) { v0[e] = sigmoidf_(v0[e]); v1[e] = sigmoidf_(v1[e]); }
                        *(u32x4*)(gates + (size_t)row * 2048 + col0 + bj * HALF) = pk8(v0, v1); } }
        } else {
            u32x4 ov[2][4][2]; float rsv[2][4];
#pragma unroll
            for (int ai = 0; ai < 2; ++ai)
#pragma unroll
                for (int m = 0; m < 4; ++m) { const int row = u.pm * BM + ai * HALF + wr * 64 + m * 16 + fr; rsv[ai][m] = rstd[row];
#pragma unroll
                    for (int bj = 0; bj < 2; ++bj) ov[ai][m][bj] = *(const u32x4*)(oa + (size_t)row * 1024 + col0 + bj * HALF); }
#pragma unroll
            for (int ai = 0; ai < 2; ++ai)
#pragma unroll
                for (int m = 0; m < 4; ++m) { const int row = u.pm * BM + ai * HALF + wr * 64 + m * 16 + fr; const float rs = rsv[ai][m];
#pragma unroll
                    for (int bj = 0; bj < 2; ++bj) { const f32x4 z0 = acc[ai][bj][m][0] * rs, z1 = acc[ai][bj][m][1] * rs; const u32x4 o = ov[ai][m][bj];
                        f32x4 a0 = {bflo(o.x), bfhi(o.x), bflo(o.y), bfhi(o.y)}, a1 = {bflo(o.z), bfhi(o.z), bflo(o.w), bfhi(o.w)};
#pragma unroll
                        for (int e = 0; e < 4; ++e) { a0[e] *= z0[e] * sigmoidf_(z0[e]); a1[e] *= z1[e] * sigmoidf_(z1[e]); }
                        *(u32x4*)(oa + (size_t)row * 1024 + col0 + bj * HALF) = pk8(a0, a1); } }
        }
    }
};
struct EpiP3b {
    static constexpr bool PERM = true, AFTER_DRAIN = false;
    const bf16_t* gates; bf16_t* merged;
    __device__ __forceinline__ void operator()(const f32x4 (&acc)[2][2][4][2], const Unit& u, int wr, int wc, int fr, int fq) const {
        const bool second = u.pn >= 4; const int col0 = (u.pn & 3) * BM + wc * 32 + 8 * fq;
#pragma unroll
        for (int ai = 0; ai < 2; ++ai) { u32x4 gv[4][2], tv[4][2];
#pragma unroll
            for (int m = 0; m < 4; ++m) { const int row = u.pm * BM + ai * HALF + wr * 64 + m * 16 + fr;
#pragma unroll
                for (int bj = 0; bj < 2; ++bj) { gv[m][bj] = *(const u32x4*)(gates + (size_t)row * 2048 + (second ? 1024 : 0) + col0 + bj * HALF);
                    tv[m][bj] = second ? *(const u32x4*)(merged + (size_t)row * 1024 + col0 + bj * HALF) : (u32x4){0u, 0u, 0u, 0u}; } }
#pragma unroll
            for (int m = 0; m < 4; ++m) { const int row = u.pm * BM + ai * HALF + wr * 64 + m * 16 + fr;
#pragma unroll
                for (int bj = 0; bj < 2; ++bj) { const u32x4 g = gv[m][bj], t = tv[m][bj];
                    const f32x4 g0 = {bflo(g.x), bfhi(g.x), bflo(g.y), bfhi(g.y)}, g1 = {bflo(g.z), bfhi(g.z), bflo(g.w), bfhi(g.w)};
                    const f32x4 v0 = acc[ai][bj][m][0] * g0 + (f32x4){bflo(t.x), bfhi(t.x), bflo(t.y), bfhi(t.y)}, v1 = acc[ai][bj][m][1] * g1 + (f32x4){bflo(t.z), bfhi(t.z), bflo(t.w), bfhi(t.w)};
                    *(u32x4*)(merged + (size_t)row * 1024 + col0 + bj * HALF) = pk8(v0, v1); } }
            asm volatile("" ::: "memory"); }
    }
};
struct EpiRes {
    static constexpr bool PERM = false, AFTER_DRAIN = false;
    const float* res; float* xo; bf16_t* xb; float* ss;
    __device__ __forceinline__ void operator()(const f32x4 (&acc)[2][2][4][2], const Unit& u, int wr, int wc, int fr, int fq) const {
        const int col0 = u.pn * BM + wc * 32 + 4 * fq;
#pragma unroll
        for (int ai = 0; ai < 2; ++ai) { f32x4 rv[4][2][2];
#pragma unroll
            for (int m = 0; m < 4; ++m) { const size_t off = (size_t)(u.pm * BM + ai * HALF + wr * 64 + m * 16 + fr) * 1024 + col0;
#pragma unroll
                for (int bj = 0; bj < 2; ++bj)
#pragma unroll
                    for (int n = 0; n < 2; ++n) rv[m][bj][n] = *(const f32x4*)(res + off + bj * HALF + n * 16); }
#pragma unroll
            for (int m = 0; m < 4; ++m) { const int row = u.pm * BM + ai * HALF + wr * 64 + m * 16 + fr; const size_t off = (size_t)row * 1024 + col0; float s = 0.f;
#pragma unroll
                for (int bj = 0; bj < 2; ++bj)
#pragma unroll
                    for (int n = 0; n < 2; ++n) { const size_t o = off + bj * HALF + n * 16; const f32x4 v = rv[m][bj][n] + acc[ai][bj][m][n]; *(f32x4*)(xo + o) = v;
                        s += (v[0] * v[0] + v[1] * v[1]) + (v[2] * v[2] + v[3] * v[3]);
                        if (xb) { u32x2 w; w.x = cvt_pk_bf16(v[0], v[1]); w.y = cvt_pk_bf16(v[2], v[3]); *(u32x2*)(xb + o) = w; } }
                s += __shfl_xor(s, 16); s += __shfl_xor(s, 32);
                if (fq == 0) ss[(size_t)row * 16 + u.pn * 4 + wc] = s; }
            asm volatile("" ::: "memory"); }
    }
};
struct EpiRowBf16 {
    static constexpr bool PERM = true, AFTER_DRAIN = false;
    bf16_t* out; int ldc; const float* rs1; const float* ss16;
    __device__ __forceinline__ void operator()(const f32x4 (&acc)[2][2][4][2], const Unit& u, int wr, int wc, int fr, int fq) const {
        const int col0 = u.pn * BM + wc * 32 + 8 * fq;
#pragma unroll
        for (int ai = 0; ai < 2; ++ai)
#pragma unroll
            for (int m = 0; m < 4; ++m) { const int row = u.pm * BM + ai * HALF + wr * 64 + m * 16 + fr; const float rs = ss16 ? rstd16(ss16 + (size_t)row * 16) : rs1[row];
#pragma unroll
                for (int bj = 0; bj < 2; ++bj) *(u32x4*)(out + (size_t)row * ldc + col0 + bj * HALF) = pk8(acc[ai][bj][m][0] * rs, acc[ai][bj][m][1] * rs); }
    }
};
struct EpiAct {
    static constexpr bool PERM = true, AFTER_DRAIN = false;
    bf16_t* act; const float* ss16;
    __device__ __forceinline__ void operator()(const f32x4 (&acc)[2][2][4][2], const Unit& u, int wr, int wc, int fr, int fq) const {
        const int col0 = u.pn * HALF + wc * 32 + 8 * fq;
#pragma unroll
        for (int ai = 0; ai < 2; ++ai)
#pragma unroll
            for (int m = 0; m < 4; ++m) { const int row = u.pm * BM + ai * HALF + wr * 64 + m * 16 + fr; const float rs = rstd16(ss16 + (size_t)row * 16);
                f32x4 a[2];
#pragma unroll
                for (int n = 0; n < 2; ++n) { const f32x4 g = acc[ai][0][m][n] * rs, up = acc[ai][1][m][n] * rs;
#pragma unroll
                    for (int e = 0; e < 4; ++e) a[n][e] = g[e] * sigmoidf_(g[e]) * up[e]; }
                *(u32x4*)(act + (size_t)row * 2816 + col0) = pk8(a[0], a[1]); }
    }
};
struct PairOrder {
    StaticOrder so;
    __device__ void init(int M, int G_, int c_) { so.init(M, 1024, G_, c_); }
    __device__ bool next(int i, Unit& u) const { if (!so.next(i >> 1, u)) return false; u.pn += 4 * (i & 1); return true; }
    __device__ __forceinline__ void a_ready(const Unit&) const {}
    __device__ __forceinline__ void done(const Unit&) const {}
};
template <class Epi, class Sched, bool ALIGN_EPI = false, bool SP2 = false>
__device__ __forceinline__ void gemm_phase(PG8_LAS unsigned char* lds, const Gemm g, const Sched& S, const Epi& E, const int wid) {
    const int lane = lane_id(), tid = wid * 64 + lane, wr = wid >> 2, wc = wid & 3, fr = lane & 15, fq = lane >> 4;
    const int K = g.K, nt = K / BK;
    unsigned voffA[2], voffB[2];
#pragma unroll
    for (int i = 0; i < 2; ++i) { int R, C; stage_rc(tid * 16 + i * 8192, R, C); const int Rb = Epi::PERM ? ((R & ~31) + perm32(R & 31)) : R;
        voffA[i] = (unsigned)(R * K + C) * 2u; voffB[i] = (unsigned)(Rb * K + C) * 2u; }
    const size_t kstep = (size_t)(BK * 2);
    const size_t hstep = (size_t)HALF * K * 2;
    const size_t tstep = 2 * hstep;
    const unsigned ldsw = (unsigned)wid * 1024u;
    const int aoff = lds_byte(wr * 64 + fr, fq * 8), boff = lds_byte(wc * 32 + fr, fq * 8);
#define PG8_SA(b, h) (((b) * 2 + (h)) * HTB)
#define PG8_SB(b, h) ((4 + (b) * 2 + (h)) * HTB)
#define PG8_STAGE(bufoff, gbase, voff) do { _Pragma("unroll") for (int _i = 0; _i < 2; ++_i) \
        __builtin_amdgcn_global_load_lds((const unsigned*)((const char*)(gbase) + (voff)[_i]), (PG8_LAS unsigned*)(lds + (bufoff) + ldsw + _i * 8192), 16, 0, 0); } while (0)
#define PG8_LDA(dst, b, h) do { _Pragma("unroll") for (int m = 0; m < 4; ++m) _Pragma("unroll") for (int k = 0; k < 2; ++k) dst[m][k] = *(const PG8_LAS bf16x8*)(lds + PG8_SA(b, h) + aoff + m * 2048 + k * 1024); } while (0)
#define PG8_LDB(dst, b, h) do { _Pragma("unroll") for (int n = 0; n < 2; ++n) _Pragma("unroll") for (int k = 0; k < 2; ++k) dst[n][k] = *(const PG8_LAS bf16x8*)(lds + PG8_SB(b, h) + boff + n * 2048 + k * 1024); } while (0)
#define PG8_MMA(ai, bj, At, Bt) do { __builtin_amdgcn_s_setprio(1); _Pragma("unroll") for (int m = 0; m < 4; ++m) _Pragma("unroll") for (int n = 0; n < 2; ++n) _Pragma("unroll") for (int k = 0; k < 2; ++k) \
        acc[ai][bj][m][n] = __builtin_amdgcn_mfma_f32_16x16x32_bf16(Bt[n][k], At[m][k], acc[ai][bj][m][n], 0, 0, 0); __builtin_amdgcn_s_setprio(0); } while (0)
#define PG8_WAIT_V(n) asm volatile("s_waitcnt vmcnt(" #n ")" ::: "memory")
#define PG8_WAIT_L(n) asm volatile("s_waitcnt lgkmcnt(" #n ")" ::: "memory")
#define PG8_BAR __builtin_amdgcn_s_barrier()
#define PG8_SCHED __builtin_amdgcn_sched_barrier(0)
    Unit cur, nxt; int ui = 0;
    if (!S.next(0, cur)) return;
    f32x4 acc[2][2][4][2];
#pragma unroll
    for (int a = 0; a < 2; ++a)
#pragma unroll
        for (int b = 0; b < 2; ++b)
#pragma unroll
            for (int m = 0; m < 4; ++m)
#pragma unroll
                for (int n = 0; n < 2; ++n) acc[a][b][m][n] = (f32x4){0.f, 0.f, 0.f, 0.f};
    bf16x8 At[4][2], B0[2][2], B1[2][2];
    const char* cA = (const char*)g.A + (size_t)cur.pm * tstep + (cur.pn >= g.a_split ? g.a_delta : 0L); const char* cB = (const char*)g.Bt + (size_t)cur.pn * tstep;
    S.a_ready(cur);
    if constexpr (SP2) {
        PG8_STAGE(PG8_SB(0, 0), cB, voffB); PG8_STAGE(PG8_SB(0, 1), cB + hstep, voffB); PG8_STAGE(PG8_SA(0, 0), cA, voffA); PG8_STAGE(PG8_SA(0, 1), cA + hstep, voffA);
        if (wr == 1) PG8_BAR;
        PG8_WAIT_V(2); PG8_BAR;
        PG8_STAGE(PG8_SB(1, 0), cB + kstep, voffB); PG8_STAGE(PG8_SA(1, 0), cA + kstep, voffA); PG8_STAGE(PG8_SB(1, 1), cB + hstep + kstep, voffB);
        PG8_WAIT_V(6); PG8_BAR;
    } else {
        PG8_STAGE(PG8_SB(0, 0), cB, voffB); PG8_STAGE(PG8_SA(0, 0), cA, voffA); PG8_STAGE(PG8_SB(0, 1), cB + hstep, voffB); PG8_STAGE(PG8_SA(0, 1), cA + hstep, voffA);
        if (wr == 1) PG8_BAR;
        PG8_WAIT_V(4); PG8_BAR;
        PG8_STAGE(PG8_SB(1, 0), cB + kstep, voffB); PG8_STAGE(PG8_SA(1, 0), cA + kstep, voffA); PG8_STAGE(PG8_SB(1, 1), cB + hstep + kstep, voffB);
        PG8_WAIT_V(6); PG8_BAR;
    }
    for (;;) {
        const bool has_next = S.next(ui + 1, nxt);
        const char* nA = has_next ? (const char*)g.A + (size_t)nxt.pm * tstep + (nxt.pn >= g.a_split ? g.a_delta : 0L) : cA; const char* nB = has_next ? (const char*)g.Bt + (size_t)nxt.pn * tstep : cB;
        for (int t = 0; t < nt; t += 2) {
            const bool last = (t == nt - 2);
            const char* a1 = cA + (size_t)(t + 1) * kstep;
            const char* a2 = last ? nA : cA + (size_t)(t + 2) * kstep; const char* b2 = last ? nB : cB + (size_t)(t + 2) * kstep;
            const char* a3 = a2 + kstep; const char* b3 = b2 + kstep;
            if (last && has_next) S.a_ready(nxt);
            if constexpr (SP2) {
            PG8_LDB(B0, 0, 0); PG8_LDB(B1, 0, 1); PG8_SCHED; PG8_LDA(At, 0, 0); PG8_STAGE(PG8_SA(1, 1), a1 + hstep, voffA);
            PG8_WAIT_V(8); PG8_WAIT_L(0); PG8_BAR; PG8_MMA(0, 0, At, B0); PG8_MMA(0, 1, At, B1); PG8_BAR; PG8_SCHED;
            PG8_LDA(At, 0, 1); PG8_STAGE(PG8_SB(0, 0), b2, voffB); PG8_STAGE(PG8_SB(0, 1), b2 + hstep, voffB); PG8_STAGE(PG8_SA(0, 0), a2, voffA);
            PG8_WAIT_V(8); PG8_WAIT_L(0); PG8_BAR; PG8_MMA(1, 0, At, B0); PG8_MMA(1, 1, At, B1); PG8_BAR; PG8_SCHED;
            PG8_LDB(B0, 1, 0); PG8_LDB(B1, 1, 1); PG8_SCHED; PG8_LDA(At, 1, 0); PG8_STAGE(PG8_SA(0, 1), a2 + hstep, voffA);
            PG8_WAIT_V(8); PG8_WAIT_L(0); PG8_BAR; PG8_MMA(0, 0, At, B0); PG8_MMA(0, 1, At, B1); PG8_BAR; PG8_SCHED;
            PG8_LDA(At, 1, 1); PG8_STAGE(PG8_SB(1, 0), b3, voffB); PG8_STAGE(PG8_SB(1, 1), b3 + hstep, voffB); PG8_STAGE(PG8_SA(1, 0), a3, voffA);
            PG8_WAIT_V(8); PG8_WAIT_L(0); PG8_BAR; PG8_MMA(1, 0, At, B0); PG8_MMA(1, 1, At, B1); PG8_BAR; PG8_SCHED;
            } else {
            PG8_LDB(B0, 0, 0); PG8_SCHED; PG8_LDA(At, 0, 0); PG8_STAGE(PG8_SA(1, 1), a1 + hstep, voffA);
            PG8_WAIT_L(8); PG8_BAR; PG8_WAIT_L(0); PG8_MMA(0, 0, At, B0); PG8_BAR; PG8_SCHED;
            PG8_LDB(B1, 0, 1); PG8_STAGE(PG8_SB(0, 0), b2, voffB);
            PG8_BAR; PG8_WAIT_L(0); PG8_MMA(0, 1, At, B1); PG8_BAR;
            PG8_LDA(At, 0, 1); PG8_STAGE(PG8_SA(0, 0), a2, voffA);
            PG8_BAR; PG8_WAIT_L(0); PG8_MMA(1, 0, At, B0); PG8_BAR; PG8_SCHED;
            PG8_STAGE(PG8_SB(0, 1), b2 + hstep, voffB);
            PG8_WAIT_V(6); PG8_BAR; PG8_MMA(1, 1, At, B1); PG8_BAR;
            PG8_LDB(B0, 1, 0); PG8_SCHED; PG8_LDA(At, 1, 0); PG8_STAGE(PG8_SA(0, 1), a2 + hstep, voffA);
            PG8_WAIT_L(8); PG8_BAR; PG8_WAIT_L(0); PG8_MMA(0, 0, At, B0); PG8_BAR; PG8_SCHED;
            PG8_LDB(B1, 1, 1); PG8_STAGE(PG8_SB(1, 0), b3, voffB);
            PG8_BAR; PG8_WAIT_L(0); PG8_MMA(0, 1, At, B1); PG8_BAR;
            PG8_LDA(At, 1, 1); PG8_STAGE(PG8_SA(1, 0), a3, voffA);
            PG8_BAR; PG8_WAIT_L(0); PG8_MMA(1, 0, At, B0); PG8_BAR; PG8_SCHED;
            PG8_STAGE(PG8_SB(1, 1), b3 + hstep, voffB);
            PG8_WAIT_V(6); PG8_BAR; PG8_MMA(1, 1, At, B1); PG8_BAR;
            }
        }
        if constexpr (ALIGN_EPI) { if (wr == 0) PG8_BAR; }
        if constexpr (!Epi::AFTER_DRAIN) { E(acc, cur, wr, wc, fr, fq); S.done(cur); }
        if (!has_next) break;
#pragma unroll
        for (int a = 0; a < 2; ++a)
#pragma unroll
            for (int b = 0; b < 2; ++b)
#pragma unroll
                for (int m = 0; m < 4; ++m)
#pragma unroll
                    for (int n = 0; n < 2; ++n) acc[a][b][m][n] = (f32x4){0.f, 0.f, 0.f, 0.f};
        cur = nxt; cA = nA; cB = nB; ++ui;
        if constexpr (ALIGN_EPI) { if (wr == 1) PG8_BAR; }
    }
    PG8_WAIT_V(0);
    if constexpr (!ALIGN_EPI) { if (wr == 0) PG8_BAR; }
    PG8_BAR;
    if constexpr (Epi::AFTER_DRAIN) { E.fused(acc, cur, wr, wc, fr, fq, lds, wid, lane); S.done(cur); }
#undef PG8_SA
#undef PG8_SB
#undef PG8_STAGE
#undef PG8_LDA
#undef PG8_LDB
#undef PG8_MMA
#undef PG8_WAIT_V
#undef PG8_WAIT_L
#undef PG8_BAR
#undef PG8_SCHED
}
}
#include <hip/hip_bf16.h>
#include <cmath>
namespace attn_body {
using bf16=__hip_bfloat16;
using bf16x8=__attribute__((ext_vector_type(8)))short;
using s16x4=__attribute__((ext_vector_type(4)))short;
using f32x16=__attribute__((ext_vector_type(16)))float;
using u32x4=__attribute__((ext_vector_type(4)))unsigned;
constexpr int BATCH=4,NHEAD=16,SEQ=4096,D=64,DM=1024;
constexpr int NW=8,QBLK=32,QB=QBLK*NW,KVBLK=64,NQB=SEQ/QB;
constexpr int ATTN_PITCH=DM, ATTN_UNIT_ROWS=QB;
__device__ __forceinline__ int crow(int r,int hi){return (r&3)+8*(r>>2)+4*hi;}
#define SBAR() __builtin_amdgcn_sched_barrier(0)
__device__ __forceinline__ void cmask(f32x16&p0,f32x16&p1,int jb,int qrel,int hi){
  const float NEG=-INFINITY; int kb=64*jb+4*hi;
  #pragma unroll
  for(int r=0;r<16;++r){int kv=kb+(r&3)+8*(r>>2); if(kv>qrel)p0[r]=NEG; if(kv+32>qrel)p1[r]=NEG;}
}

constexpr int NSLOT=3, SLOTB=8192;
constexpr int LDS_K=0, LDS_V=NSLOT*SLOTB, LDS_WS=2*NSLOT*SLOTB, LDS_OST=LDS_WS+NW*64*4, LDS_STA=LDS_OST+NW*4096, LDS_STC=LDS_STA+NW*4096, LDS_BYTES=LDS_STC+NW*4096;
constexpr float C2=0.125f*1.4426950408889634f;
__device__ __forceinline__ void glds16(const void*gsrc,unsigned lds_dst){unsigned keep;
  asm volatile("s_mov_b32 %0, m0\n\ts_mov_b32 m0, %2\n\ts_nop 0\n\tglobal_load_lds_dwordx4 %1, off\n\ts_mov_b32 m0, %0":"=&s"(keep):"v"(gsrc),"s"(lds_dst):"memory");}
__device__ __forceinline__ float max3f(float a,float b,float c){float r;asm("v_max3_f32 %0, %1, %2, %3":"=v"(r):"v"(a),"v"(b),"v"(c));return r;}
__device__ __forceinline__ float max2f(float a,float b){float r;asm("v_max_f32_e32 %0, %1, %2":"=v"(r):"v"(a),"v"(b));return r;}
__device__ __forceinline__ float fadd_s(float a,float b){float r;asm("v_add_f32_e32 %0, %1, %2":"=v"(r):"v"(a),"v"(b));return r;}
__device__ __forceinline__ float fsub_s(float a,float b){float r;asm("v_sub_f32_e32 %0, %1, %2":"=v"(r):"v"(a),"v"(b));return r;}
typedef float f32x2_t __attribute__((ext_vector_type(2))); typedef __bf16 bf16x2_t __attribute__((ext_vector_type(2)));
__device__ __forceinline__ unsigned cvtpk_s(float lo,float hi){f32x2_t v={lo,hi};bf16x2_t b=__builtin_convertvector(v,bf16x2_t);return __builtin_bit_cast(unsigned,b);}
#define WAIT_BAR(N) asm volatile("s_waitcnt vmcnt(" #N ") lgkmcnt(0)\n\ts_barrier":::"memory")

__device__ __forceinline__ void qkt(f32x16&p0,f32x16&p1,const char*Kslot,const bf16x8*qr,const f32x16&negm,int r32,int hi){
  const char*kb=Kslot+hi*1024+r32*16;
  #pragma unroll
  for(int d0=0;d0<4;++d0){
    const bf16x8 b0=*reinterpret_cast<const bf16x8*>(kb+d0*2048);
    const bf16x8 b1=*reinterpret_cast<const bf16x8*>(kb+d0*2048+512);
    if(d0==0){p0=__builtin_amdgcn_mfma_f32_32x32x16_bf16(b0,qr[0],negm,0,0,0);p1=__builtin_amdgcn_mfma_f32_32x32x16_bf16(b1,qr[0],negm,0,0,0);}
    else{p0=__builtin_amdgcn_mfma_f32_32x32x16_bf16(b0,qr[d0],p0,0,0,0);p1=__builtin_amdgcn_mfma_f32_32x32x16_bf16(b1,qr[d0],p1,0,0,0);}}
}
typedef __attribute__((address_space(3))) const char* lds_cptr;
typedef short v4i16_t __attribute__((ext_vector_type(4)));
__device__ __forceinline__ void kload8(bf16x8*kf,lds_cptr kp){
  kf[0]=*(const __attribute__((address_space(3))) bf16x8*)(kp);      kf[1]=*(const __attribute__((address_space(3))) bf16x8*)(kp+512);
  kf[2]=*(const __attribute__((address_space(3))) bf16x8*)(kp+2048); kf[3]=*(const __attribute__((address_space(3))) bf16x8*)(kp+2560);
  kf[4]=*(const __attribute__((address_space(3))) bf16x8*)(kp+4096); kf[5]=*(const __attribute__((address_space(3))) bf16x8*)(kp+4608);
  kf[6]=*(const __attribute__((address_space(3))) bf16x8*)(kp+6144); kf[7]=*(const __attribute__((address_space(3))) bf16x8*)(kp+6656);
}
__device__ __forceinline__ void kload2(bf16x8*kf,lds_cptr kp,int j){ kf[2*j]=*(const __attribute__((address_space(3))) bf16x8*)(kp+j*2048); kf[2*j+1]=*(const __attribute__((address_space(3))) bf16x8*)(kp+j*2048+512); }
__device__ __forceinline__ s16x4 vtr(lds_cptr p){ return __builtin_bit_cast(s16x4,__builtin_amdgcn_ds_read_tr16_b64_v4i16((__attribute__((address_space(3))) v4i16_t*)p)); }
__device__ __forceinline__ float rowmax(const f32x16&p0,const f32x16&p1){
  float a=max3f(p0[0],p0[1],p1[0]),b=max3f(p0[2],p0[3],p1[1]);a=max3f(a,p1[2],p1[3]);
  #pragma unroll
  for(int r=4;r<16;r+=4){a=max3f(a,p0[r],p0[r+1]);b=max3f(b,p0[r+2],p0[r+3]);a=max3f(a,p1[r],p1[r+1]);b=max3f(b,p1[r+2],p1[r+3]);}
  const float m=max2f(a,b);
  auto rr=__builtin_amdgcn_permlane32_swap(__float_as_uint(m),__float_as_uint(m),false,false);
  return max2f(__uint_as_float(rr[0]),__uint_as_float(rr[1]));
}
__device__ __forceinline__ void pv(f32x16*o,int vb,bf16x8 pa0,bf16x8 pa1,bf16x8 pa2,bf16x8 pa3){
  #pragma unroll
  for(int d0=0;d0<2;++d0){s16x4 lo[4],hi[4];
    #pragma unroll
    for(int ks=0;ks<4;++ks){
      asm volatile("ds_read_b64_tr_b16 %0,%1 offset:%c2":"=&v"(lo[ks]):"v"(vb),"i"(d0*4096+ks*1024):"memory");
      asm volatile("ds_read_b64_tr_b16 %0,%1 offset:%c2":"=&v"(hi[ks]):"v"(vb),"i"(d0*4096+ks*1024+512):"memory");}
    asm volatile("s_waitcnt lgkmcnt(0)":::"memory");SBAR();
    #define PK(k) (bf16x8){lo[k][0],lo[k][1],lo[k][2],lo[k][3],hi[k][0],hi[k][1],hi[k][2],hi[k][3]}
    o[d0]=__builtin_amdgcn_mfma_f32_32x32x16_bf16(pa0,PK(0),o[d0],0,0,0);
    o[d0]=__builtin_amdgcn_mfma_f32_32x32x16_bf16(pa1,PK(1),o[d0],0,0,0);
    o[d0]=__builtin_amdgcn_mfma_f32_32x32x16_bf16(pa2,PK(2),o[d0],0,0,0);
    o[d0]=__builtin_amdgcn_mfma_f32_32x32x16_bf16(pa3,PK(3),o[d0],0,0,0);
    #undef PK
  }
}

#ifndef ATTN_STORE16
#define ATTN_STORE16(p,v) (*(u32x4*)(p)=(v))
#endif
template<int THRL> __device__ __forceinline__ void attn_unit(int b,int qcol,int vcol,int ocol,int qb,int mode,float lam,const bf16*Q,const bf16*K,const bf16*V,bf16*O,char*shm,const int wid){
  const int lane=lane_id(),r32=lane&31,hi=lane>>5;
  const long rowbase=(long)b*SEQ; const int q0=qb*QB;
  const bf16*Qw=Q+(rowbase+q0+wid*QBLK)*DM+qcol;
  const bf16*Kh=K+rowbase*DM+qcol,*Vh=V+rowbase*DM+vcol;
  const unsigned lds0=(unsigned)(uintptr_t)shm;
  float*wsf=(float*)(shm+LDS_WS)+wid*64;
  const bf16*ksrc=Kh+(long)lane*DM+wid*8;
  const bf16*vsrc=Vh+(long)(16*(wid&3)+(lane>>2))*DM+(wid>>2)*32+(lane&3)*8;
  const unsigned kdst=lds0+LDS_K+wid*1024, vdst=lds0+LDS_V+wid*1024;
  #define DMA_K(t,slot) glds16(ksrc+(long)(t)*KVBLK*DM,(unsigned)__builtin_amdgcn_readfirstlane(kdst+(slot)))
  #define DMA_V(t,slot) glds16(vsrc+(long)(t)*KVBLK*DM,(unsigned)__builtin_amdgcn_readfirstlane(vdst+(slot)))
  const int vb0=(int)(lds0+LDS_V)+((lane>>4)&1)*32+(lane&3)*8+(4*hi+((lane&15)>>2))*64;
  const char*Kbase=shm+LDS_K; bf16x8 kf[8];
  const lds_cptr shm3=(lds_cptr)shm; const lds_cptr kp0=shm3+LDS_K+hi*1024+r32*16; const lds_cptr vp0=shm3+LDS_V+((lane>>4)&1)*32+(lane&3)*8+(4*hi+((lane&15)>>2))*64;
  const int NT=(q0+QB)/KVBLK;
  DMA_K(0,0);DMA_V(0,0);DMA_K(1,SLOTB);
  bf16x8 qr[4];
  #pragma unroll
  for(int d0=0;d0<4;++d0)qr[d0]=*reinterpret_cast<const bf16x8*>(&Qw[(long)r32*DM+d0*16+hi*8]);
  float mhat=0.f,l_reg=0.f;f32x16 o[2];o[0]=f32x16{};o[1]=f32x16{};f32x16 negm=f32x16{};asm volatile("":"+v"(negm));
  const int qrel=wid*QBLK+r32;
  #define CMASK(P0,P1,t) do{int jb_=(t)-(NT-4); if(jb_>=0)cmask(P0,P1,jb_,qrel,hi);}while(0)
  bool resc=false;
  #define START(P0,P1) do{ const float rm=rowmax(P0,P1); resc=false; \
    { const float dl=rm; mhat=fadd_s(mhat,dl); \
      _Pragma("unroll") for(int r=0;r<16;++r){P0[r]=fsub_s(P0[r],dl);P1[r]=fsub_s(P1[r],dl);} \
      _Pragma("unroll") for(int r=0;r<16;++r)negm[r]=-mhat; asm volatile("":"+v"(negm)); } \
    _Pragma("unroll") for(int r=0;r<16;++r)P0[r]=__builtin_amdgcn_exp2f(P0[r]); }while(0)
  #define RESC() do{ if(resc){ asm volatile("s_waitcnt lgkmcnt(0)":::"memory"); \
      _Pragma("unroll") for(int d_=0;d_<2;++d_) _Pragma("unroll") for(int r=0;r<16;++r)o[d_][r]*=wsf[crow(r,hi)]; } }while(0)
  f32x16 pA0,pA1,pB0,pB1;
  int sl_prev=0,sl_cur=0,sl_next=SLOTB;
  #define ROT() do{sl_prev=sl_cur;sl_cur=sl_next;sl_next=(sl_next==(NSLOT-1)*SLOTB)?0:sl_next+SLOTB;}while(0)
  DMA_K(2,2*SLOTB);
  WAIT_BAR(3);
  qkt(pA0,pA1,Kbase,qr,negm,r32,hi);asm volatile("s_nop 15\n\ts_nop 7":"+v"(pA0),"+v"(pA1));CMASK(pA0,pA1,0);
  START(pA0,pA1);
  _Pragma("unroll") for(int r=0;r<16;++r)pA1[r]=__builtin_amdgcn_exp2f(pA1[r]);
  WAIT_BAR(0);
  DMA_K(3,0);DMA_V(1,SLOTB);
  ROT();
  kload8(kf,kp0+sl_cur);
  WAIT_BAR(2);
  s16x4 vlo[8],vhi[8]; u32x4 pw0,pw1,pw2,pw3;
  #define PKW(P,B) cvtpk_s(P[B],P[B+1])
  #define PAF(k) __builtin_bit_cast(bf16x8,pw##k)
  #define VFR(i) (bf16x8){vlo[i][0],vlo[i][1],vlo[i][2],vlo[i][3],vhi[i][0],vhi[i][1],vhi[i][2],vhi[i][3]}
  #define PIN(x) asm volatile("":"+v"(x))
  #define MX3(a,b,c) __builtin_fmaxf(__builtin_fmaxf((a),(b)),(c))
  #define GAPA(MF,A0,A1,A2,A3,W0,W1,PW) do{ MF; sacc+=A0; sacc+=A1; sacc+=A2; sacc+=A3; PIN(sacc); W0; W1; PIN(PW); SBAR(); }while(0)
  #define EX(v) __builtin_amdgcn_exp2f(v)
  #define GAPB(MF,X,B) do{ MF; X[B]=EX(X[B]); X[B+1]=EX(X[B+1]); X[B+2]=EX(X[B+2]); X[B+3]=EX(X[B+3]); PIN(X); SBAR(); }while(0)
  #define VRD(i) do{ vlo[i]=vtr(vp_+(((i)>>2)*4096+((i)&3)*1024)); vhi[i]=vtr(vp_+(((i)>>2)*4096+((i)&3)*1024+512)); }while(0)
  #define KRD(G,j) do{ if(G){ kload2(kf,kp0+sl_next,j); SBAR(); } }while(0)
  #define STEP(C0,C1,P0,P1,t,GK,GV,GL) do{ SBAR(); \
    const lds_cptr vp_=vp0+sl_prev; \
    VRD(0); SBAR(); float sacc=(P0[0]+P0[1]); \
    GAPA(C0=__builtin_amdgcn_mfma_f32_32x32x16_bf16(kf[0],qr[0],negm,0,0,0), P0[2],P0[3],P0[4],P0[5],     pw0[0]=PKW(P0,0), pw0[1]=PKW(P0,2), pw0); \
    VRD(4); SBAR(); GAPA(C1=__builtin_amdgcn_mfma_f32_32x32x16_bf16(kf[1],qr[0],negm,0,0,0), P0[6],P0[7],P0[8],P0[9],     pw0[2]=PKW(P0,4), pw0[3]=PKW(P0,6), pw0); \
    VRD(1); SBAR(); GAPA(C0=__builtin_amdgcn_mfma_f32_32x32x16_bf16(kf[2],qr[1],C0,0,0,0),   P0[10],P0[11],P0[12],P0[13], pw1[0]=PKW(P0,8), pw1[1]=PKW(P0,10), pw1); \
    VRD(5); SBAR(); GAPA(C1=__builtin_amdgcn_mfma_f32_32x32x16_bf16(kf[3],qr[1],C1,0,0,0),   P0[14],P0[15],P1[0],P1[1],   pw1[2]=PKW(P0,12),pw1[3]=PKW(P0,14), pw1); \
    VRD(2); SBAR(); GAPA(C0=__builtin_amdgcn_mfma_f32_32x32x16_bf16(kf[4],qr[2],C0,0,0,0),   P1[2],P1[3],P1[4],P1[5],     pw2[0]=PKW(P1,0), pw2[1]=PKW(P1,2), pw2); \
    VRD(6); SBAR(); GAPA(C1=__builtin_amdgcn_mfma_f32_32x32x16_bf16(kf[5],qr[2],C1,0,0,0),   P1[6],P1[7],P1[8],P1[9],     pw2[2]=PKW(P1,4), pw2[3]=PKW(P1,6), pw2); \
    VRD(3); SBAR(); GAPA(C0=__builtin_amdgcn_mfma_f32_32x32x16_bf16(kf[6],qr[3],C0,0,0,0),   P1[10],P1[11],P1[12],P1[13], pw3[0]=PKW(P1,8), pw3[1]=PKW(P1,10), pw3); \
    VRD(7); SBAR(); GAPA(C1=__builtin_amdgcn_mfma_f32_32x32x16_bf16(kf[7],qr[3],C1,0,0,0),   P1[14],P1[15],0.f,0.f,       pw3[2]=PKW(P1,12),pw3[3]=PKW(P1,14), pw3); \
    l_reg+=sacc; \
    if(GK){DMA_K((t)+3,sl_cur);} if(GV){DMA_V((t)+1,sl_next);} \
    CMASK(C0,C1,t); \
    { float a=MX3(C0[0],C0[1],C1[0]),b=MX3(C0[2],C0[3],C1[1]); a=MX3(a,C1[2],C1[3]); \
      _Pragma("unroll") for(int r=4;r<16;r+=4){a=MX3(a,C0[r],C0[r+1]);b=MX3(b,C0[r+2],C0[r+3]);a=MX3(a,C1[r],C1[r+1]);b=MX3(b,C1[r+2],C1[r+3]);} \
      float rm=__builtin_fmaxf(a,b); { auto rr=__builtin_amdgcn_permlane32_swap(__float_as_uint(rm),__float_as_uint(rm),false,false); rm=__builtin_fmaxf(__uint_as_float(rr[0]),__uint_as_float(rr[1])); } \
      resc=false; \
      if(__builtin_expect(__any(rm>(float)THRL),0)){ const float dl=__builtin_fmaxf(rm,0.f); mhat+=dl; \
        _Pragma("unroll") for(int r=0;r<16;++r){C0[r]-=dl;C1[r]-=dl;} \
        _Pragma("unroll") for(int r=0;r<16;++r)negm[r]=-mhat; asm volatile("":"+v"(negm)); \
        const float f=__builtin_amdgcn_exp2f(-dl); l_reg*=f; if(hi==0)wsf[r32]=f; resc=true; } } \
    SBAR(); \
    GAPB(o[0]=__builtin_amdgcn_mfma_f32_32x32x16_bf16(PAF(0),VFR(0),o[0],0,0,0), C0,0); \
    GAPB(o[1]=__builtin_amdgcn_mfma_f32_32x32x16_bf16(PAF(0),VFR(4),o[1],0,0,0), C0,4); \
    KRD(GL,0); GAPB(o[0]=__builtin_amdgcn_mfma_f32_32x32x16_bf16(PAF(1),VFR(1),o[0],0,0,0), C0,8); \
    KRD(GL,1); GAPB(o[1]=__builtin_amdgcn_mfma_f32_32x32x16_bf16(PAF(1),VFR(5),o[1],0,0,0), C0,12); \
    KRD(GL,2); GAPB(o[0]=__builtin_amdgcn_mfma_f32_32x32x16_bf16(PAF(2),VFR(2),o[0],0,0,0), C1,0); \
    KRD(GL,3); GAPB(o[1]=__builtin_amdgcn_mfma_f32_32x32x16_bf16(PAF(2),VFR(6),o[1],0,0,0), C1,4); \
    GAPB(o[0]=__builtin_amdgcn_mfma_f32_32x32x16_bf16(PAF(3),VFR(3),o[0],0,0,0), C1,8); \
    GAPB(o[1]=__builtin_amdgcn_mfma_f32_32x32x16_bf16(PAF(3),VFR(7),o[1],0,0,0), C1,12); \
    }while(0)
  int t=1;
  #undef CMASK
  #define CMASK(P0,P1,t) do{}while(0)
  for(;t+5<NT;t+=2){
    STEP(pB0,pB1,pA0,pA1,t,true,true,true);     WAIT_BAR(2); RESC(); ROT();
    STEP(pA0,pA1,pB0,pB1,t+1,true,true,true);   WAIT_BAR(2); RESC(); ROT();
  }
  #undef CMASK
  #define CMASK(P0,P1,t) do{int jb_=(t)-(NT-4); if(jb_>=0)cmask(P0,P1,jb_,qrel,hi);}while(0)
  #define ENDW(tt) do{ if((tt)+3<NT){WAIT_BAR(2);} else if((tt)+2<NT){WAIT_BAR(1);} else {WAIT_BAR(0);} }while(0)
  for(;t+1<NT;t+=2){
    STEP(pB0,pB1,pA0,pA1,t,(t+3<NT),(t+1<NT),(t+1<NT));       ENDW(t);   RESC(); ROT();
    STEP(pA0,pA1,pB0,pB1,t+1,(t+4<NT),(t+2<NT),(t+2<NT));     ENDW(t+1); RESC(); ROT();
  }
  STEP(pB0,pB1,pA0,pA1,NT-1,false,false,false); RESC();
  { float sacc=pB0[0]+pB0[1]; _Pragma("unroll") for(int r=2;r<16;++r)sacc+=pB0[r]; _Pragma("unroll") for(int r=0;r<16;++r)sacc+=pB1[r]; l_reg+=sacc;
    pw0=(u32x4){PKW(pB0,0),PKW(pB0,2),PKW(pB0,4),PKW(pB0,6)};pw1=(u32x4){PKW(pB0,8),PKW(pB0,10),PKW(pB0,12),PKW(pB0,14)};pw2=(u32x4){PKW(pB1,0),PKW(pB1,2),PKW(pB1,4),PKW(pB1,6)};pw3=(u32x4){PKW(pB1,8),PKW(pB1,10),PKW(pB1,12),PKW(pB1,14)};
    SBAR(); pv(o,vb0+sl_cur,PAF(0),PAF(1),PAF(2),PAF(3)); }
  #undef PKW
  #undef PAF
  #undef VFR
  #undef PIN
  #undef MX3
  #undef GAPA
  #undef GAPB
  #undef EX
  #undef VRD
  #undef KRD
  #undef STEP
  #undef ENDW
  {auto rr=__builtin_amdgcn_permlane32_swap(__float_as_uint(l_reg),__float_as_uint(l_reg),false,false);l_reg=__uint_as_float(rr[0])+__uint_as_float(rr[1]);}
  if(hi==0)wsf[32+r32]=l_reg;asm volatile("s_waitcnt lgkmcnt(0)":::"memory");
  float rli[16];
  #pragma unroll
  for(int r=0;r<16;++r)rli[r]=__builtin_amdgcn_rcpf(wsf[32+crow(r,hi)]);
  bf16*Ow=O+(rowbase+q0+wid*QBLK)*DM+ocol;
  { bf16*stg=(bf16*)(shm+((mode&1)?LDS_OST:LDS_STA))+wid*2048;
    #pragma unroll
    for(int r=0;r<16;++r){const int orow=crow(r,hi);
      #pragma unroll
      for(int d0=0;d0<2;++d0)stg[orow*64+d0*32+r32]=__float2bfloat16(o[d0][r]*rli[r]);}
    asm volatile("s_waitcnt lgkmcnt(0)":::"memory");
#ifndef ATT_NO_EPI2
    if(mode&1){ const bf16*sa=(const bf16*)(shm+LDS_STA)+wid*2048; bf16*sc=(bf16*)(shm+LDS_STC)+wid*2048;
      int ln=lane; asm volatile("":"+v"(ln));
      #pragma unroll 1
      for(int i=0;i<4;++i){const int row=i*8+(ln>>3),ch=ln&7,idx=row*64+ch*8; const u32x4 av=*(const u32x4*)(sa+idx),bv=*(const u32x4*)(stg+idx);
        float c[8];
        #pragma unroll
        for(int k=0;k<4;++k){ c[2*k]=__uint_as_float(av[k]<<16)-lam*__uint_as_float(bv[k]<<16); c[2*k+1]=__uint_as_float(av[k]&0xffff0000u)-lam*__uint_as_float(bv[k]&0xffff0000u); }
        if(mode==1){ u32x4 w; w[0]=cvtpk_s(c[0],c[1]);w[1]=cvtpk_s(c[2],c[3]);w[2]=cvtpk_s(c[4],c[5]);w[3]=cvtpk_s(c[6],c[7]); *(u32x4*)(sc+idx)=w; }
        else { const u32x4 cv=*(const u32x4*)(sc+idx); float c0[8];
          #pragma unroll
          for(int k=0;k<4;++k){ c0[2*k]=__uint_as_float(cv[k]<<16); c0[2*k+1]=__uint_as_float(cv[k]&0xffff0000u); }
          float ss=0.f;
          #pragma unroll
          for(int k=0;k<8;++k)ss+=c0[k]*c0[k]+c[k]*c[k];
          ss+=__shfl_xor(ss,1);ss+=__shfl_xor(ss,2);ss+=__shfl_xor(ss,4);
          const float rs=1.0f/sqrtf(ss*(1.0f/128.0f)+1e-6f);
          u32x4 w0,w1;
          w0[0]=cvtpk_s(c0[0]*rs,c0[1]*rs);w0[1]=cvtpk_s(c0[2]*rs,c0[3]*rs);w0[2]=cvtpk_s(c0[4]*rs,c0[5]*rs);w0[3]=cvtpk_s(c0[6]*rs,c0[7]*rs);
          w1[0]=cvtpk_s(c[0]*rs,c[1]*rs);w1[1]=cvtpk_s(c[2]*rs,c[3]*rs);w1[2]=cvtpk_s(c[4]*rs,c[5]*rs);w1[3]=cvtpk_s(c[6]*rs,c[7]*rs);
          *(u32x4*)(Ow+(long)row*DM+ch*8)=w0; *(u32x4*)(Ow+(long)row*DM+64+ch*8)=w1; }
      }
      asm volatile("s_waitcnt lgkmcnt(0)":::"memory");
    }
#endif
    }
  asm volatile("s_waitcnt lgkmcnt(0)\n\ts_barrier":::"memory");
  #undef DMA_K
  #undef DMA_V
  #undef CMASK
  #undef START
  #undef RESC
  #undef ROT
}
constexpr int ATTN_LDS_BYTES=LDS_BYTES;
#undef SBAR
#undef WAIT_BAR
}
constexpr int NWAVES = 8;
constexpr int TOK = 16384, DMODEL = 1024, NBATCH = 4, SEQL = 4096, MEMT = 1024  , DFF = 2816;
constexpr size_t MiB = 1u << 20;
constexpr size_t WS_CTL = 0, CTL_ZERO_BYTES = 1 * MiB;
constexpr size_t WS_RSTD0 = 1 * MiB, WS_RSTDM = WS_RSTD0 + 65536, WS_WAB = WS_RSTD0 + 131072, WS_GVAL = WS_RSTD0 + 262144, WS_BETA = WS_GVAL + 524288, WS_RCOS = WS_BETA + 524288, WS_RSIN = WS_RCOS + 524288;
constexpr size_t WS_SS1 = 4 * MiB, WS_SS2 = 5 * MiB, WS_SS3 = 6 * MiB, WS_KVC = 7 * MiB, WS_MEMB = 9 * MiB;
constexpr size_t WS_W1 = 11 * MiB, WS_WGZ = 23 * MiB, WS_WOUTA = 29 * MiB, WS_WOUTB = 31 * MiB, WS_WO = 33 * MiB, WS_WCQ = 35 * MiB, WS_WCKV = 36 * MiB, WS_WCO = 38 * MiB, WS_WFFI = 39 * MiB, WS_WFFO = 50 * MiB;
constexpr size_t WS_XB = 56 * MiB;
constexpr size_t WS_QB = 88 * MiB, WS_KB = 120 * MiB, WS_VB = 152 * MiB, WS_VA = 184 * MiB, WS_OA = 216 * MiB, WS_END = 256 * MiB;
constexpr size_t WS_X1 = 88 * MiB, WS_X1B = 152 * MiB, WS_MERGED = 184 * MiB, WS_QC = 216 * MiB, WS_OC = 232 * MiB, WS_ACT = 88 * MiB;
static_assert(WS_RSIN + 524288 <= WS_SS1 && WS_WFFO + (size_t)1024 * DFF * 2 <= WS_XB && WS_ACT + (size_t)TOK * DFF * 2 <= WS_VA && WS_OA + (size_t)TOK * 2048 <= WS_END - 8 * MiB, "d_ws map");
constexpr int CW_TMO = 0, CW_CODE = 1, CW_BAR = 4096, CW_QUEUE = 8192, CW_DBG = 8256;
constexpr int SCR_BYTES = 162816, LDSCTL_OFF = SCR_BYTES, MISC_OFF = LDSCTL_OFF + 320, LDS_BYTES = 163840;

#define GAS __attribute__((address_space(1)))
#define LAS __attribute__((address_space(3)))
typedef unsigned short bf16;
typedef unsigned v4u __attribute__((ext_vector_type(4)));
typedef unsigned v2u __attribute__((ext_vector_type(2)));
typedef float f32x4 __attribute__((ext_vector_type(4)));
typedef float f32x16 __attribute__((ext_vector_type(16)));
typedef short bf16x8 __attribute__((ext_vector_type(8)));
typedef short s16x4 __attribute__((ext_vector_type(4)));
#define GAS __attribute__((address_space(1)))
#define LAS __attribute__((address_space(3)))
typedef unsigned short bf16;
typedef unsigned v4u __attribute__((ext_vector_type(4)));
typedef float f32x4 __attribute__((ext_vector_type(4)));
typedef short bf16x8 __attribute__((ext_vector_type(8)));
typedef GAS unsigned gu32;
typedef GAS unsigned long long gu64;
#define RLX_AGENT __ATOMIC_RELAXED, __HIP_MEMORY_SCOPE_AGENT
#define LDS_WAIT() asm volatile("s_waitcnt lgkmcnt(0)" ::: "memory")
#define VM_WAIT() asm volatile("s_waitcnt vmcnt(0)" ::: "memory")
__device__ __forceinline__ unsigned long long rt() { return __builtin_amdgcn_s_memrealtime(); }
__device__ __forceinline__ unsigned f2bf(float f) { unsigned u = __builtin_bit_cast(unsigned, f); return (u + 0x7fffu + ((u >> 16) & 1u)) >> 16; }
__device__ __forceinline__ unsigned pk2(float lo, float hi) { return f2bf(lo) | (f2bf(hi) << 16); }

#define XB_TMO      128
#define XB_XCNT(j)  (256  + 64 * (j))
#define XB_XSUB(j)  (1280 + 64 * (j))
#define XB_XGEN(j)  (2304 + 64 * (j))
#define XB_TOP      3328
#define XB_TOPGEN   3392
#define XCD_BAR_WORDS 3456
#define XB_SPIN_CAP (1u << 18)

__device__ __forceinline__ unsigned xb_ld(unsigned* p)              { return __hip_atomic_load(p, __ATOMIC_RELAXED, __HIP_MEMORY_SCOPE_AGENT); }
__device__ __forceinline__ unsigned xb_add(unsigned* p, unsigned v) { return __hip_atomic_fetch_add(p, v, __ATOMIC_RELAXED, __HIP_MEMORY_SCOPE_AGENT); }
__device__ __forceinline__ unsigned xb_xcc_id() { return (unsigned)__builtin_amdgcn_s_getreg((3 << 11) | 20) & 0xFu; }
#define XB_SPIN(cond, bar) do { unsigned _sp = 0; while (cond) { __builtin_amdgcn_s_sleep(1); \
    if ((++_sp & 255u) == 0u) { if (xb_ld(&(bar)[XB_TMO])) break; if (_sp > XB_SPIN_CAP) { atomicAdd(&(bar)[XB_TMO], 1u); break; } } } } while (0)

struct XcdBarrier {
    unsigned* bar; unsigned x;
    volatile LAS unsigned* st;
};

__device__ __forceinline__ XcdBarrier xcd_barrier_post(unsigned* bar, volatile LAS unsigned* st, const bool t0) {
    XcdBarrier b; b.bar = bar; b.x = xb_xcc_id(); b.st = st;
    if (t0) (void)xb_add(&bar[XB_XCNT(b.x)], 1u);
    return b;
}
__device__ __forceinline__ void xcd_barrier_complete(unsigned* bar, unsigned x, unsigned& nloc, unsigned& nx) {
    const unsigned G = gridDim.x * gridDim.y * gridDim.z;
    unsigned sum, cnt, mine, sp = 0u;
    for (;;) {
        sum = 0u; cnt = 0u; mine = 0u;
#pragma unroll
        for (unsigned j = 0; j < 16; ++j) { const unsigned c = xb_ld(&bar[XB_XCNT(j)]); sum += c; cnt += (c > 0u) ? 1u : 0u; mine = (j == x) ? c : mine; }
        if (sum == G) break;
        __builtin_amdgcn_s_sleep(1);
        if ((++sp & 255u) == 0u) { if (xb_ld(&bar[XB_TMO])) break; if (sp > XB_SPIN_CAP) { atomicAdd(&bar[XB_TMO], 1u); break; } }
    }
    nloc = mine > 0u ? mine : 1u; nx = cnt > 0u ? cnt : 1u;
}

__device__ __forceinline__ void xcd_barrier(const XcdBarrier& b, const bool t0) {
    asm volatile("s_waitcnt vmcnt(0)" ::: "memory");
    __syncthreads();
    if (t0) {
        unsigned* bar = b.bar;
        __builtin_amdgcn_s_waitcnt(0);
        unsigned nloc = b.st[0], nx = b.st[1];
        if (nloc == 0u) { xcd_barrier_complete(bar, b.x, nloc, nx); b.st[0] = nloc; b.st[1] = nx; }
        const unsigned old = xb_add(&bar[XB_XSUB(b.x)], 1u);
        const unsigned gen = old / nloc;
        if (old + 1u == (gen + 1u) * nloc) {
            __builtin_amdgcn_fence(__ATOMIC_RELEASE, "agent");
            asm volatile("s_waitcnt vmcnt(0)" ::: "memory");
            const unsigned og = xb_add(&bar[XB_TOP], 1u);
            const unsigned tg = og / nx;
            if (og + 1u == (tg + 1u) * nx) xb_add(&bar[XB_TOPGEN], 1u);
            else XB_SPIN(xb_ld(&bar[XB_TOPGEN]) == tg, bar);
            __builtin_amdgcn_fence(__ATOMIC_ACQUIRE, "agent");
            xb_add(&bar[XB_XGEN(b.x)], 1u);
            asm volatile("s_waitcnt vmcnt(0)" ::: "memory");
        } else {
            XB_SPIN(xb_ld(&bar[XB_XGEN(b.x)]) == gen, bar);
            __builtin_amdgcn_fence(__ATOMIC_ACQUIRE, "agent");
            asm volatile("s_waitcnt vmcnt(0)" ::: "memory");
        }
    }
    __syncthreads();
}
struct Args { const void* in[27]; float* out; unsigned char* ws; float invf[8]; };
struct Frame {
    LAS unsigned char* lds; volatile LAS unsigned* MISC; gu32* ctl;
    int wave, vcu, G;
};
__device__ __forceinline__ float wave_sum(float v) {
#pragma unroll
    for (int o = 1; o < 64; o <<= 1) v += __shfl_xor(v, o);
    return v;
}
__device__ __forceinline__ unsigned pk2r(float lo, float hi) { typedef float f2 __attribute__((ext_vector_type(2))); typedef __bf16 b2 __attribute__((ext_vector_type(2))); f2 v = {lo, hi}; b2 b = __builtin_convertvector(v, b2); return __builtin_bit_cast(unsigned, b); }

__device__ __forceinline__ void tr_item(const float* W, int ldw, int scol0, int K, bf16* WT, int drow0, const float* gain, int gmask, float gscale, int mode, LAS float* scr, int item, int nblk, int lane) {
    const int kb = item / nblk, nb = item - kb * nblk, k0 = 64 * kb, n0 = 32 * nb;
    int sc = scol0 + n0;
    if (mode == 3) { const int j = n0 >> 8, wi = n0 & 255; sc = (wi < 128) ? j * 128 + wi : DFF + j * 128 + (wi - 128); }
    const int kr = lane >> 3, nq = lane & 7; f32x4 v[8]; float gv[8];
#pragma unroll
    for (int i = 0; i < 8; ++i) { v[i] = *(const GAS f32x4*)(W + (size_t)(k0 + 8 * i + kr) * ldw + sc + 4 * nq); gv[i] = gain ? gain[(k0 + 8 * i + kr) & gmask] * gscale : gscale; }
#pragma unroll
    for (int i = 0; i < 8; ++i) { LAS float* d = scr + (8 * i + kr) * 33 + 4 * nq; d[0] = v[i][0] * gv[i]; d[1] = v[i][1] * gv[i]; d[2] = v[i][2] * gv[i]; d[3] = v[i][3] * gv[i]; }
    LDS_WAIT(); asm volatile("" ::: "memory");
    const int c = lane & 7;
#pragma unroll
    for (int j = 0; j < 4; ++j) { const int n = (lane >> 3) + 8 * j; const LAS float* s = scr + (8 * c) * 33 + n;
        v4u o; o.x = pk2r(s[0 * 33], s[1 * 33]); o.y = pk2r(s[2 * 33], s[3 * 33]); o.z = pk2r(s[4 * 33], s[5 * 33]); o.w = pk2r(s[6 * 33], s[7 * 33]);
        *(GAS v4u*)(WT + (size_t)(drow0 + n0 + n) * K + k0 + 8 * c) = o; }
    LDS_WAIT(); asm volatile("" ::: "memory");
}
#define TR_MAT(W, ldw, scol0, K, WT, drow0, nrows, gain, gmask, gscale, mode) do { const int nblk_ = (nrows) / 32, nit_ = ((K) / 64) * nblk_; \
    for (int it_ = (gw - base % NGW + NGW) % NGW; it_ < nit_; it_ += NGW) tr_item((W), (ldw), (scol0), (K), (WT), (drow0), (gain), (gmask), (gscale), (mode), scr, it_, nblk_, lane); base += nit_; } while (0)
template <int NR> __device__ __forceinline__ void rows_to_bf16(const float* x, bf16* o, float* rstd_out, int m0, int mstride, int mend, int lane) {
    f32x4 v[NR][4]; float s[NR];
#pragma unroll
    for (int r = 0; r < NR; ++r) { const int m = m0 + r * mstride; s[r] = 0.f;
        if (m < mend) { const GAS f32x4* xr = (const GAS f32x4*)(x + (size_t)m * 1024) + lane;
#pragma unroll
            for (int j = 0; j < 4; ++j) v[r][j] = xr[64 * j]; } }
#pragma unroll
    for (int r = 0; r < NR; ++r)
#pragma unroll
        for (int j = 0; j < 4; ++j) s[r] += (v[r][j].x * v[r][j].x + v[r][j].y * v[r][j].y) + (v[r][j].z * v[r][j].z + v[r][j].w * v[r][j].w);
#pragma unroll
    for (int off = 1; off < 64; off <<= 1)
#pragma unroll
        for (int r = 0; r < NR; ++r) s[r] += __shfl_xor(s[r], off);
#pragma unroll
    for (int r = 0; r < NR; ++r) { const int m = m0 + r * mstride;
        if (m < mend) { GAS v2u* o8 = (GAS v2u*)(o + (size_t)m * 1024) + lane;
#pragma unroll
            for (int j = 0; j < 4; ++j) { v2u w; w.x = pk2r(v[r][j].x, v[r][j].y); w.y = pk2r(v[r][j].z, v[r][j].w); o8[64 * j] = w; }
            if (lane == 0) rstd_out[m] = 1.0f / sqrtf(s[r] * (1.0f / 1024.0f) + 1e-6f); } }
}
constexpr float C2Q = 0.125f * 1.4426950408889634f;
constexpr float C2X = 0.08838834764831845f * 1.4426950408889634f;
__device__ __forceinline__ void p0_prologue(Frame& F, const Args& A, unsigned char* ws) {
    LAS float* scr = (LAS float*)(F.lds + F.wave * 16384); const int lane = lane_id(), tid = F.wave * 64 + lane;
    const int gw = F.vcu * NWAVES + F.wave, NGW = F.G * NWAVES; int base = 0;
    const float* g_mix = (const float*)A.in[3]; const float* w_in = (const float*)A.in[4];
    TR_MAT(w_in, 7184, 0, 1024, (bf16*)(ws + WS_W1), 0, 3072, g_mix, 1023, 1.0f, 0);
    TR_MAT(w_in, 7184, 4112, 1024, (bf16*)(ws + WS_W1), 3072, 3072, g_mix, 1023, 1.0f, 0);
    TR_MAT((const float*)A.in[14], 2048, 0, 1024, (bf16*)(ws + WS_WGZ), 0, 2048, g_mix, 1023, 1.0f, 0);
    TR_MAT(w_in, 7184, 3072, 1024, (bf16*)(ws + WS_WGZ), 2048, 1024, g_mix, 1023, 1.0f, 0);
    TR_MAT((const float*)A.in[15], 1024, 0, 1024, (bf16*)(ws + WS_WOUTA), 0, 1024, (const float*)A.in[8], 127, 1.0f, 0);
    TR_MAT((const float*)A.in[16], 1024, 0, 1024, (bf16*)(ws + WS_WOUTB), 0, 1024, (const float*)A.in[13], 127, 0.8f, 0);
    TR_MAT((const float*)A.in[17], 1024, 0, 1024, (bf16*)(ws + WS_WO), 0, 1024, (const float*)nullptr, 0, 1.0f, 0);
    TR_MAT((const float*)A.in[20], 512, 0, 1024, (bf16*)(ws + WS_WCQ), 0, 512, (const float*)A.in[18], 1023, C2X, 0);
    TR_MAT((const float*)A.in[21], 1024, 0, 1024, (bf16*)(ws + WS_WCKV), 0, 1024, (const float*)A.in[19], 1023, 1.0f, 0);
    TR_MAT((const float*)A.in[22], 1024, 0, 512, (bf16*)(ws + WS_WCO), 0, 1024, (const float*)nullptr, 0, 1.0f, 0);
    TR_MAT((const float*)A.in[24], 2 * DFF, 0, 1024, (bf16*)(ws + WS_WFFI), 0, 2 * DFF, (const float*)A.in[23], 1023, 1.0f, 3);
    TR_MAT((const float*)A.in[25], 1024, 0, DFF, (bf16*)(ws + WS_WFFO), 0, 1024, (const float*)nullptr, 0, 1.0f, 0);
    const float* x = (const float*)A.in[0]; const float* mem = (const float*)A.in[1];
    for (int m = gw; m < TOK; m += 4 * NGW) rows_to_bf16<4>(x, (bf16*)(ws + WS_XB), (float*)(ws + WS_RSTD0), m, NGW, TOK, lane);
    for (int m = gw; m < MEMT; m += NGW) rows_to_bf16<1>(mem, (bf16*)(ws + WS_MEMB), (float*)(ws + WS_RSTDM), m, NGW, MEMT, lane);
    const int gt = F.vcu * (NWAVES * 64) + tid, NGT = F.G * NWAVES * 64;
    const int* pos = (const int*)A.in[2];
    for (int i = gt; i < TOK * 8; i += NGT) { const float ang = (float)pos[i >> 3] * A.invf[i & 7]; double rev = (double)ang * 0.15915494309189535; rev -= (double)(long long)rev; const float rf = (float)rev;
        ((float*)(ws + WS_RCOS))[i] = __builtin_amdgcn_cosf(rf); ((float*)(ws + WS_RSIN))[i] = __builtin_amdgcn_sinf(rf); }
    for (int i = gt; i < 16 * 1024; i += NGT) { const int n = i >> 10, k = i & 1023; ((bf16*)(ws + WS_WAB))[i] = (bf16)(pk2r(w_in[(size_t)k * 7184 + 4096 + n] * g_mix[k], 0.f) & 0xffffu); }
}
__device__ __forceinline__ void ab_unit(Frame& F, const Args& A, unsigned char* ws, int mu) {
    typedef float f4 __attribute__((ext_vector_type(4)));
    const int rb = F.wave & 3, kh = F.wave >> 2, t0 = mu * 64, l = lane_id(), tid = F.wave * 64 + l;
    const bf16* xb = (const bf16*)(ws + WS_XB) + (size_t)(t0 + 16 * rb + (l & 15)) * 1024 + kh * 512 + 8 * (l >> 4);
    const bf16* wb = (const bf16*)(ws + WS_WAB) + (size_t)(l & 15) * 1024 + kh * 512 + 8 * (l >> 4);
    f4 acc = {0.f, 0.f, 0.f, 0.f};
#pragma unroll 4
    for (int ks = 0; ks < 16; ++ks) { const bf16x8 a = *(const bf16x8*)(xb + ks * 32), b = *(const bf16x8*)(wb + ks * 32); acc = __builtin_amdgcn_mfma_f32_16x16x32_bf16(a, b, acc, 0, 0, 0); }
    LAS float* red = (LAS float*)F.lds;
#pragma unroll
    for (int r = 0; r < 4; ++r) red[(kh * 4 + rb) * 256 + (4 * (l >> 4) + r) * 16 + (l & 15)] = acc[r];
    __syncthreads();
    const float* a_log = (const float*)A.in[6]; const float* dt_bias = (const float*)A.in[7];
#pragma unroll
    for (int j = 0; j < 2; ++j) { const int o = tid + 512 * j, row = o >> 4, col = o & 15;
        float v = red[(row >> 4) * 256 + (row & 15) * 16 + col] + red[(4 + (row >> 4)) * 256 + (row & 15) * 16 + col];
        v *= ((const float*)(ws + WS_RSTD0))[t0 + row];
        if (col < 8) { const float xx = v + dt_bias[col]; const float sp = xx > 20.f ? xx : log1pf(__expf(xx)); ((float*)(ws + WS_GVAL))[(size_t)(t0 + row) * 8 + col] = -__expf(a_log[col]) * sp; }
        else ((float*)(ws + WS_BETA))[(size_t)(t0 + row) * 8 + (col - 8)] = 1.0f / (1.0f + __expf(-v)); }
    __syncthreads();
}
__device__ __forceinline__ void final_rows(Frame& F, float* out, const float* ss3, const float* g_final) {
    const int gw = F.vcu * NWAVES + F.wave, NGW = F.G * NWAVES, lane = lane_id();
    f32x4 g[4];
#pragma unroll
    for (int j = 0; j < 4; ++j) g[j] = *((const GAS f32x4*)g_final + lane + 64 * j);
    for (int m = gw; m < TOK; m += NGW) { const float rs = pg8::rstd16(ss3 + (size_t)m * 16); GAS f32x4* o = (GAS f32x4*)(out + (size_t)m * 1024) + lane;
#pragma unroll
        for (int j = 0; j < 4; ++j) { const f32x4 v = o[64 * j]; o[64 * j] = v * rs * g[j]; } }
}
#ifndef TPROBE
#define TPROBE -1
#endif
#define GDN_TIME (TPROBE >= 100)
namespace gdn {
constexpr int L_RV = 0, L_RK = 32768, L_LM = 65536, L_KN = 81920, L_QN = 98304, L_QD = 114688, L_KDT = 131072, L_AT = 147456, L_GC = 155648, L_BYTES = 156672;
constexpr int IMG_W = 0, IMG_QD = 16384, IMG_KDT = 32768, IMG_U = 49152, IMG_AT = 65536, IMG_BYTES = 71680, SC_O = 2 * IMG_BYTES, SC_GL = SC_O + 16384, SC_BYTES = SC_GL + 512;
static_assert(SC_BYTES <= SCR_BYTES, "gdn scan LDS");
constexpr size_t WS_ATG = 11 * MiB, WS_HALO = 248 * MiB, WS_GLAST = 253 * MiB;
__device__ __forceinline__ int at_off(int bi, int row, int chunk) { return bi * 2048 + row * 64 + ((chunk ^ ((row >> 2) & 3)) << 4); }

static_assert(L_BYTES <= SCR_BYTES, "gdn LDS");
__device__ __forceinline__ int sw256(int row, int chunk) { return row * 256 + ((chunk ^ (row & 15)) << 4); }
__device__ __forceinline__ int sw128(int row, int chunk) { return row * 128 + ((chunk ^ ((row >> 1) & 7)) << 4); }
__device__ __forceinline__ int crow(int r, int hi) { return (r & 3) + 8 * (r >> 2) + 4 * hi; }
__device__ __forceinline__ bf16x8 frag2(const LAS unsigned char* tile, int off0, int off1) { const v2u a = *(const LAS v2u*)(tile + off0), b = *(const LAS v2u*)(tile + off1); v4u w = {a.x, a.y, b.x, b.y}; return __builtin_bit_cast(bf16x8, w); }
__device__ __forceinline__ bf16x8 packacc(const f32x16& v, int s) { v4u w; w.x = pk2r(v[8 * s + 0], v[8 * s + 1]); w.y = pk2r(v[8 * s + 2], v[8 * s + 3]); w.z = pk2r(v[8 * s + 4], v[8 * s + 5]); w.w = pk2r(v[8 * s + 6], v[8 * s + 7]); return __builtin_bit_cast(bf16x8, w); }
__device__ __forceinline__ float siluf_(float x) { return x * __builtin_amdgcn_rcpf(1.0f + __builtin_amdgcn_exp2f(-1.4426950408889634f * x)); }

constexpr int SOLVE_NGRP = 528, SOLVE_PF = 10, SOLVE_RING = SOLVE_PF + 1;
constexpr int grp_row(int g) { int i = 1; for (;;) { const int n = (i + 3) / 4; if (g < n) return i; g -= n; ++i; } }
constexpr int grp_m4(int g) { int i = 1; for (;;) { const int n = (i + 3) / 4; if (g < n) return g; g -= n; ++i; } }
template <int G> __device__ __forceinline__ void solve_load(f32x4 (&buf)[SOLVE_RING], const LAS unsigned char* lm) {
    if constexpr (G < SOLVE_NGRP) { constexpr int r = grp_row(G), m = grp_m4(G); buf[G % SOLVE_RING] = *(const LAS f32x4*)(lm + r * 256 + m * 16); }
}
template <int G> __device__ __forceinline__ void solve_step(float (&x)[64], f32x4 (&buf)[SOLVE_RING], const LAS unsigned char* lm) {
    solve_load<G + SOLVE_PF>(buf, lm);
    constexpr int i = grp_row(G), m4 = grp_m4(G); const f32x4 lq = buf[G % SOLVE_RING];
    if constexpr (4 * m4 + 0 < i) x[i] -= lq[0] * x[4 * m4 + 0];
    if constexpr (4 * m4 + 1 < i) x[i] -= lq[1] * x[4 * m4 + 1];
    if constexpr (4 * m4 + 2 < i) x[i] -= lq[2] * x[4 * m4 + 2];
    if constexpr (4 * m4 + 3 < i) x[i] -= lq[3] * x[4 * m4 + 3];
    __builtin_amdgcn_sched_barrier(0);
}
template <int... Gs> __device__ __forceinline__ void solve_all(float (&x)[64], f32x4 (&buf)[SOLVE_RING], const LAS unsigned char* lm, std::integer_sequence<int, Gs...>) { (solve_step<Gs>(x, buf, lm), ...); }
template <int... Gs> __device__ __forceinline__ void solve_pro(f32x4 (&buf)[SOLVE_RING], const LAS unsigned char* lm, std::integer_sequence<int, Gs...>) { (solve_load<Gs>(buf, lm), ...); }

constexpr int L_CW = L_BYTES;
static_assert(L_CW + 6144 <= SCR_BYTES, "gdn prep LDS");
__device__ __forceinline__ void prep_raw(v4u (&raw)[3][5], const unsigned char* ws, const float* dout, int u, int tid) {
    const int b = u >> 9, h = (u >> 6) & 7, ch = u & 63, rp = tid >> 4, g = tid & 15;
    const bf16* QA = (const bf16*)dout; const bf16* KA = (const bf16*)dout + (size_t)TOK * 1024; const bf16* VA = (const bf16*)(ws + WS_VA); const bf16* HALO = (const bf16*)(ws + WS_HALO);
    const size_t grow0 = (size_t)b * SEQL + ch * 64;
#pragma unroll
    for (int X = 0; X < 3; ++X) { const bf16* src = (X == 0 ? QA : X == 1 ? KA : VA) + grow0 * 1024 + h * 128 + 8 * g;
#pragma unroll
        for (int j = 0; j < 5; ++j) { const int rel = 2 * rp - 3 + j; v4u r = {0u, 0u, 0u, 0u};
            if (rel >= 0) r = *(const GAS v4u*)(src + (ptrdiff_t)rel * 1024); else if (ch > 0) r = *(const GAS v4u*)(HALO + ((size_t)((b * 64 + ch - 1) * 3 + (rel + 3))) * 3072 + X * 1024 + h * 128 + 8 * g);
            raw[X][j] = r; } }
}
__device__ __forceinline__ void prep_block(Frame& F, const Args& A, unsigned char* ws, float* dout, int cidx, int G) {
    LAS unsigned char* L = F.lds; const int wave = F.wave;
    bf16* QA = (bf16*)dout; bf16* KA = (bf16*)dout + (size_t)TOK * 1024; bf16* VA = (bf16*)(ws + WS_VA); bf16* OA = (bf16*)(ws + WS_OA);
    const float* conv_w = (const float*)A.in[5]; const float* gval = (const float*)(ws + WS_GVAL); const float* beta = (const float*)(ws + WS_BETA);
    LAS float* RV = (LAS float*)(L + L_RV); LAS float* RK = (LAS float*)(L + L_RK); LAS float* LM = (LAS float*)(L + L_LM); LAS float* GC = (LAS float*)(L + L_GC); LAS float* CW = (LAS float*)(L + L_CW);
    constexpr int NU = NBATCH * 8 * (SEQL / 64);
    const bool packed = (G * 8 == NU);
    int u = packed ? cidx * 8 : cidx; const int ustep = packed ? 1 : G, uend = packed ? cidx * 8 + 8 : NU;
    v4u raw[3][5]; int hprev = -1; unsigned long long ta0 = 0, ta1 = 0, ta2 = 0, ta3 = 0;
    if (u < uend) prep_raw(raw, ws, dout, u, wave * 64 + lane_id());
    for (; u < uend; u += ustep) {
        const int b = u >> 9, h = (u >> 6) & 7, ch = u & 63; unsigned long long tq0 = 0, tq1 = 0, tq2 = 0, tq3 = 0, tq4 = 0; if (GDN_TIME) tq0 = rt();
        const int tb0 = ch * 64; const size_t grow0 = (size_t)b * SEQL + tb0;
        int lv = lane_id(); asm volatile("" : "+v"(lv));
        const int hi = lv >> 5, r32 = lv & 31, l = lv;
        if (h != hprev) { const int tid = wave * 64 + lv;
#pragma unroll
            for (int i = 0; i < 3; ++i) { const int e = tid + 512 * i, X = e >> 9, jj = (e >> 7) & 3, d = e & 127; CW[e] = conv_w[jj * 3072 + X * 1024 + h * 128 + d]; }
            hprev = h; __syncthreads(); }
        float gcs = gval[(grow0 + l) * 8 + h];
#pragma unroll
        for (int o = 1; o < 64; o <<= 1) { const float t = __shfl_up(gcs, o); if (l >= o) gcs += t; }
        const float glast = __shfl(gcs, 63); const float egc_l = __expf(gcs), ekd_l = __expf(glast - gcs), bt_l = beta[(grow0 + l) * 8 + h];
        if (wave == 0) { GC[l] = gcs; GC[64 + l] = egc_l; GC[128 + l] = ekd_l; GC[192 + l] = bt_l; }
        { const int g = lv & 15, rp = (wave << 2) + (lv >> 4);
#pragma unroll
            for (int X = 0; X < 3; ++X) { float o[2][8];
#pragma unroll
                for (int rr = 0; rr < 2; ++rr)
#pragma unroll
                    for (int e = 0; e < 8; ++e) o[rr][e] = 0.f;
#pragma unroll
                for (int jj = 0; jj < 4; ++jj) { const f32x4 w0 = *(const LAS f32x4*)(CW + (X * 4 + jj) * 128 + 8 * g), w1 = *(const LAS f32x4*)(CW + (X * 4 + jj) * 128 + 8 * g + 4);
#pragma unroll
                    for (int rr = 0; rr < 2; ++rr) { const v4u rw = raw[X][jj + rr];
                        o[rr][0] += w0[0] * __uint_as_float(rw.x << 16); o[rr][1] += w0[1] * __uint_as_float(rw.x & 0xffff0000u); o[rr][2] += w0[2] * __uint_as_float(rw.y << 16); o[rr][3] += w0[3] * __uint_as_float(rw.y & 0xffff0000u);
                        o[rr][4] += w1[0] * __uint_as_float(rw.z << 16); o[rr][5] += w1[1] * __uint_as_float(rw.z & 0xffff0000u); o[rr][6] += w1[2] * __uint_as_float(rw.w << 16); o[rr][7] += w1[3] * __uint_as_float(rw.w & 0xffff0000u); } }
#pragma unroll
                for (int rr = 0; rr < 2; ++rr) { const int c = 2 * rp + rr; const float egc = __shfl(egc_l, c), ekd = __shfl(ekd_l, c), bt = __shfl(bt_l, c);
                    float ss = 0.f;
#pragma unroll
                    for (int e = 0; e < 8; ++e) { o[rr][e] = siluf_(o[rr][e]); ss += o[rr][e] * o[rr][e]; }
                    if (X < 2) { ss += __shfl_xor(ss, 1); ss += __shfl_xor(ss, 2); ss += __shfl_xor(ss, 4); ss += __shfl_xor(ss, 8); const float rn = __builtin_amdgcn_rsqf(ss + 1e-6f) * (X == 0 ? 0.08838834764831845f : 1.0f);
#pragma unroll
                        for (int e = 0; e < 8; ++e) o[rr][e] *= rn; }
                    const float* oo = o[rr];
                    if (X == 0) { v4u w = {pk2r(oo[0], oo[1]), pk2r(oo[2], oo[3]), pk2r(oo[4], oo[5]), pk2r(oo[6], oo[7])}; *(LAS v4u*)(L + L_QN + sw256(c, g)) = w;
                        v4u wd = {pk2r(oo[0] * egc, oo[1] * egc), pk2r(oo[2] * egc, oo[3] * egc), pk2r(oo[4] * egc, oo[5] * egc), pk2r(oo[6] * egc, oo[7] * egc)}; *(LAS v4u*)(L + L_QD + sw256(c, g)) = wd; }
                    else if (X == 1) { v4u w = {pk2r(oo[0], oo[1]), pk2r(oo[2], oo[3]), pk2r(oo[4], oo[5]), pk2r(oo[6], oo[7])}; *(LAS v4u*)(L + L_KN + sw256(c, g)) = w;
#pragma unroll
                        for (int e = 0; e < 8; ++e) *(LAS bf16*)(L + L_KDT + sw128(8 * g + e, c >> 3) + (c & 7) * 2) = (bf16)(pk2r(oo[e] * ekd, 0.f) & 0xffffu);
                        const float f = bt * egc; *(LAS f32x4*)(RK + c * 128 + 8 * g) = (f32x4){oo[0] * f, oo[1] * f, oo[2] * f, oo[3] * f}; *(LAS f32x4*)(RK + c * 128 + 8 * g + 4) = (f32x4){oo[4] * f, oo[5] * f, oo[6] * f, oo[7] * f}; }
                    else { *(LAS f32x4*)(RV + c * 128 + 8 * g) = (f32x4){oo[0] * bt, oo[1] * bt, oo[2] * bt, oo[3] * bt}; *(LAS f32x4*)(RV + c * 128 + 8 * g + 4) = (f32x4){oo[4] * bt, oo[5] * bt, oo[6] * bt, oo[7] * bt}; } } } }
        if (u + ustep < uend) prep_raw(raw, ws, dout, u + ustep, wave * 64 + lv);
        __syncthreads(); if (GDN_TIME) tq1 = rt();
        if (wave < 6) { const bool isL = wave < 3; const int j = isL ? wave : wave - 3; const int ab = isL ? (j >= 1) : (j == 2), bb = isL ? (j == 2) : (j >= 1);
            const int arow = 32 * ab + r32, brow = 32 * bb + r32; const LAS unsigned char* At = L + L_KN; const LAS unsigned char* Bt = L + (isL ? L_KN : L_QN);
            f32x16 acc = {};
#pragma unroll
            for (int s = 0; s < 8; ++s) { const bf16x8 a = *(const LAS bf16x8*)(At + sw256(arow, 2 * s + hi)), bq = *(const LAS bf16x8*)(Bt + sw256(brow, 2 * s + hi)); acc = __builtin_amdgcn_mfma_f32_32x32x16_bf16(a, bq, acc, 0, 0, 0); }
            if (isL) { const int m = brow; const float gm = GC[m];
#pragma unroll
                for (int r = 0; r < 16; ++r) { const int c = 32 * ab + crow(r, hi); const float d = fminf(GC[c] - gm, 0.f); LM[c * 64 + m] = (c > m) ? acc[r] * GC[192 + c] * __expf(d) : 0.f; } }
            else { const int c = brow; const float gcc = GC[c];
#pragma unroll
                for (int g4 = 0; g4 < 4; ++g4) { float v[4];
#pragma unroll
                    for (int e = 0; e < 4; ++e) { const int m = 32 * ab + 8 * g4 + 4 * hi + e; const float d = fminf(gcc - GC[m], 0.f); v[e] = (c >= m) ? acc[4 * g4 + e] * __expf(d) : 0.f; }
                    v2u w = {pk2r(v[0], v[1]), pk2r(v[2], v[3])}; *(LAS v2u*)(L + L_AT + at_off(j, r32, g4) + 8 * hi) = w; } } }
        __syncthreads(); if (GDN_TIME) tq2 = rt();
        if (wave < 4) { LAS float* R = (wave < 2) ? RV : RK; const int col = 64 * (wave & 1) + lv; float x[64];
#pragma unroll
            for (int c = 0; c < 64; ++c) x[c] = R[c * 128 + col];
            int lmb = L_LM + (lv & 0); asm volatile("" : "+v"(lmb));
            f32x4 lbuf[SOLVE_RING];
            solve_pro(lbuf, L + lmb, std::make_integer_sequence<int, SOLVE_PF>{});
            solve_all(x, lbuf, L + lmb, std::make_integer_sequence<int, SOLVE_NGRP>{});
            if (wave < 2) {
#pragma unroll
                for (int c = 0; c < 64; ++c) R[c * 128 + col] = x[c]; }
            else {
#pragma unroll
                for (int c = 0; c < 64; ++c) *(LAS bf16*)(L + L_KN + sw256(c, col >> 3) + (col & 7) * 2) = (bf16)(pk2r(-x[c], 0.f) & 0xffffu); } }
        __syncthreads(); if (GDN_TIME) tq3 = rt();
        { const int tid = wave * 64 + lv; const size_t foot = (grow0 * 1024 + (size_t)h * 128);
#pragma unroll
            for (int i = 0; i < 2; ++i) { const int p = tid + 512 * i; const size_t go = foot + (size_t)(p >> 4) * 1024 + (p & 15) * 8;
                *(GAS v4u*)(OA + go) = *(const LAS v4u*)(L + L_KN + 16 * p); *(GAS v4u*)(QA + go) = *(const LAS v4u*)(L + L_QD + 16 * p); *(GAS v4u*)(KA + go) = *(const LAS v4u*)(L + L_KDT + 16 * p);
                const f32x4 u0 = *(const LAS f32x4*)(RV + 8 * p), u1 = *(const LAS f32x4*)(RV + 8 * p + 4); v4u uw = {pk2r(u0[0], u0[1]), pk2r(u0[2], u0[3]), pk2r(u1[0], u1[1]), pk2r(u1[2], u1[3])}; *(GAS v4u*)(VA + go) = uw; }
            if (tid < 384) *(GAS v4u*)(ws + WS_ATG + (size_t)((b * 8 + h) * 64 + ch) * 6144 + 16 * tid) = *(const LAS v4u*)(L + L_AT + 16 * tid);
            if (tid == 0) ((float*)(ws + WS_GLAST))[(b * 8 + h) * 64 + ch] = __expf(GC[63]); }
        __syncthreads(); if (GDN_TIME) { tq4 = rt(); ta0 += tq1 - tq0; ta1 += tq2 - tq1; ta2 += tq3 - tq2; ta3 += tq4 - tq3; }
    }
    if (GDN_TIME && cidx == 0 && wave == 0 && lane_id() == 0) { unsigned long long* tsb = (unsigned long long*)(ws + WS_CTL) + 6144 + 16; tsb[1] = ta0; tsb[2] = ta1; tsb[3] = ta2; tsb[4] = ta3; }
}

__device__ __forceinline__ void glds4(const void* gsrc, unsigned lds_dst) { unsigned keep;
    asm volatile("s_mov_b32 %0, m0\n\ts_mov_b32 m0, %2\n\ts_nop 0\n\tglobal_load_lds_dword %1, off\n\ts_mov_b32 m0, %0" : "=&s"(keep) : "v"(gsrc), "s"(lds_dst) : "memory"); }
__device__ __forceinline__ void scan_dma(const unsigned char* ws, const float* dout, int b, int h, int ch, unsigned buf, unsigned glslot, int wave, int lane) {
    const unsigned char* QA = (const unsigned char*)dout; const unsigned char* KA = QA + (size_t)TOK * 2048; const unsigned char* VA = ws + WS_VA; const unsigned char* OA = ws + WS_OA;
    const size_t footb = (((size_t)b * SEQL + ch * 64) * 1024 + (size_t)h * 128) * 2; const int unit = (b * 8 + h) * 64 + ch;
#pragma unroll 1
    for (int k = 0; k < 9; ++k) { const int q = wave + 8 * k;
        if (q < 64) { const int img = q >> 4, j = q & 15, p = 64 * j + lane; const unsigned char* base = img == 0 ? OA : img == 1 ? QA : img == 2 ? KA : VA;
            attn_body::glds16(base + footb + (size_t)(p >> 4) * 2048 + (p & 15) * 16, (unsigned)__builtin_amdgcn_readfirstlane((int)(buf + img * 16384 + 1024 * j))); }
        else if (q < 70) { const int j = q - 64; attn_body::glds16(ws + WS_ATG + (size_t)unit * 6144 + 1024 * j + 16 * lane, (unsigned)__builtin_amdgcn_readfirstlane((int)(buf + IMG_AT + 1024 * j))); } }
    if (wave == 7) glds4(ws + WS_GLAST + (size_t)(unit + lane) * 4, (unsigned)__builtin_amdgcn_readfirstlane((int)glslot));
}
__device__ __forceinline__ void scan_block(Frame& F, unsigned char* ws, float* dout, int b, int h) {
    LAS unsigned char* L = F.lds; const int wave = F.wave;
    bf16* OA = (bf16*)(ws + WS_OA);
    f32x16 S[4];
#pragma unroll
    for (int i = 0; i < 4; ++i) S[i] = (f32x16){};
    const unsigned lds0 = (unsigned)(uintptr_t)L;
    scan_dma(ws, dout, b, h, 0, lds0, lds0 + SC_GL, wave, lane_id());
    asm volatile("s_waitcnt vmcnt(0)" ::: "memory"); __builtin_amdgcn_s_barrier(); asm volatile("" ::: "memory");
    for (int ch = 0; ch < SEQL / 64; ++ch) {
        const size_t grow0 = (size_t)b * SEQL + ch * 64;
        int lv = lane_id(); asm volatile("" : "+v"(lv));
        const int hi = lv >> 5, r32 = lv & 31, l = lv;
        LAS unsigned char* IB = L + (ch & 1) * IMG_BYTES;
        if (ch + 1 < SEQL / 64) scan_dma(ws, dout, b, h, ch + 1, lds0 + ((ch + 1) & 1) * IMG_BYTES, lds0 + SC_GL + ((ch + 1) & 1) * 256, wave, lv);
        if (wave < 4) { const int dvb = wave; const float eg = *(const LAS float*)(L + SC_GL + (ch & 1) * 256);
            f32x16 av[2], ao[2];
#pragma unroll
            for (int cb = 0; cb < 2; ++cb) { ao[cb] = (f32x16){};
#pragma unroll
                for (int r = 0; r < 16; ++r) av[cb][r] = __uint_as_float((unsigned)(*(const LAS bf16*)(IB + IMG_U + ((32 * cb + crow(r, hi)) * 128 + 32 * dvb + r32) * 2)) << 16); }
#pragma unroll
            for (int d = 0; d < 4; ++d)
#pragma unroll
                for (int s = 0; s < 2; ++s) { const bf16x8 sbf = packacc(S[d], s); const int c0 = 4 * d + 2 * s;
#pragma unroll
                    for (int cb = 0; cb < 2; ++cb) { const int row = 32 * cb + r32;
                        av[cb] = __builtin_amdgcn_mfma_f32_32x32x16_bf16(frag2(IB + IMG_W, sw256(row, c0) + 8 * hi, sw256(row, c0 + 1) + 8 * hi), sbf, av[cb], 0, 0, 0);
                        ao[cb] = __builtin_amdgcn_mfma_f32_32x32x16_bf16(frag2(IB + IMG_QD, sw256(row, c0) + 8 * hi, sw256(row, c0 + 1) + 8 * hi), sbf, ao[cb], 0, 0, 0); } }
            bf16x8 vb[2][2];
#pragma unroll
            for (int mb = 0; mb < 2; ++mb) { vb[mb][0] = packacc(av[mb], 0); vb[mb][1] = packacc(av[mb], 1); }
#pragma unroll
            for (int cb = 0; cb < 2; ++cb) { const int row = 32 * cb + r32;
#pragma unroll
                for (int mb = 0; mb <= cb; ++mb)
#pragma unroll
                    for (int s = 0; s < 2; ++s) { const int bi = cb + mb; ao[cb] = __builtin_amdgcn_mfma_f32_32x32x16_bf16(frag2(IB + IMG_AT, at_off(bi, r32, 2 * s) + 8 * hi, at_off(bi, r32, 2 * s + 1) + 8 * hi), vb[mb][s], ao[cb], 0, 0, 0); } }
#pragma unroll
            for (int d = 0; d < 4; ++d) { const int row = 32 * d + r32; S[d] = S[d] * eg;
#pragma unroll
                for (int mb = 0; mb < 2; ++mb)
#pragma unroll
                    for (int s = 0; s < 2; ++s) { const int c0 = 4 * mb + 2 * s; S[d] = __builtin_amdgcn_mfma_f32_32x32x16_bf16(frag2(IB + IMG_KDT, sw128(row, c0) + 8 * hi, sw128(row, c0 + 1) + 8 * hi), vb[mb][s], S[d], 0, 0, 0); } }
#pragma unroll
            for (int cb = 0; cb < 2; ++cb)
#pragma unroll
                for (int r = 0; r < 16; ++r) { const int oc = 32 * cb + crow(r, hi), od = 32 * dvb + r32; *(LAS bf16*)(L + SC_O + sw256(oc, od >> 3) + (od & 7) * 2) = (bf16)(pk2r(ao[cb][r], 0.f) & 0xffffu); } }
        asm volatile("s_waitcnt lgkmcnt(0)" ::: "memory"); __builtin_amdgcn_s_barrier(); asm volatile("" ::: "memory");
        { const int tid = wave * 64 + lv, c = tid >> 3, sg = tid & 7;
            const v4u o0 = *(const LAS v4u*)(L + SC_O + sw256(c, 2 * sg)), o1 = *(const LAS v4u*)(L + SC_O + sw256(c, 2 * sg + 1));
            float f[16];
#pragma unroll
            for (int e = 0; e < 4; ++e) { f[2 * e] = __uint_as_float(o0[e] << 16); f[2 * e + 1] = __uint_as_float(o0[e] & 0xffff0000u); f[8 + 2 * e] = __uint_as_float(o1[e] << 16); f[9 + 2 * e] = __uint_as_float(o1[e] & 0xffff0000u); }
            float ss = 0.f;
#pragma unroll
            for (int e = 0; e < 16; ++e) ss += f[e] * f[e];
            ss += __shfl_xor(ss, 1); ss += __shfl_xor(ss, 2); ss += __shfl_xor(ss, 4);
            const float rs = __builtin_amdgcn_rsqf(ss * (1.0f / 128.0f) + 1e-6f);
            v4u w0 = {pk2r(f[0] * rs, f[1] * rs), pk2r(f[2] * rs, f[3] * rs), pk2r(f[4] * rs, f[5] * rs), pk2r(f[6] * rs, f[7] * rs)}, w1 = {pk2r(f[8] * rs, f[9] * rs), pk2r(f[10] * rs, f[11] * rs), pk2r(f[12] * rs, f[13] * rs), pk2r(f[14] * rs, f[15] * rs)};
            bf16* op = OA + (grow0 + c) * 1024 + h * 128 + 16 * sg; *(GAS v4u*)op = w0; *(GAS v4u*)(op + 8) = w1; }
        asm volatile("s_waitcnt vmcnt(2) lgkmcnt(0)" ::: "memory"); __builtin_amdgcn_s_barrier(); asm volatile("" ::: "memory");
    }
}
}
namespace xat {
constexpr int L_KC = 0, L_VT = 65536, L_WS = 131072, L_BYTES = 131072 + 8 * 256;
__device__ __forceinline__ int swVT(int row, int chunk) { return row * 512 + ((chunk ^ (row & 31)) << 4); }
__device__ __forceinline__ void unit(Frame& F, unsigned char* ws, int pm, int hd) {
    LAS unsigned char* L = F.lds; const int wave = F.wave, l = lane_id(), tid = wave * 64 + l, hi = l >> 5, r32 = l & 31;
    const bf16* QC = (const bf16*)(ws + WS_QC); const bf16* KVC = (const bf16*)(ws + WS_KVC); bf16* OC = (bf16*)(ws + WS_OC);
    const int b = pm >> 4; const size_t row0 = (size_t)pm * 256 + wave * 32;
#pragma unroll
    for (int i = 0; i < 8; ++i) { const int id = tid + 512 * i, key = id >> 4, ch = id & 15; const bf16* kp = KVC + (size_t)(b * 256 + key) * 1024 + hd * 128 + 8 * ch;
        *(LAS v4u*)(L + L_KC + gdn::sw256(key, ch)) = *(const GAS v4u*)kp;
        const v4u vv = *(const GAS v4u*)(kp + 512);
#pragma unroll
        for (int e = 0; e < 4; ++e) { const unsigned w = vv[e]; const int dv = 8 * ch + 2 * e;
            *(LAS bf16*)(L + L_VT + swVT(dv, key >> 3) + (key & 7) * 2) = (bf16)(w & 0xffffu); *(LAS bf16*)(L + L_VT + swVT(dv + 1, key >> 3) + (key & 7) * 2) = (bf16)(w >> 16); } }
    bf16x8 qr[8];
#pragma unroll
    for (int s = 0; s < 8; ++s) qr[s] = *(const GAS bf16x8*)(QC + (row0 + r32) * 512 + hd * 128 + 16 * s + 8 * hi);
    __syncthreads();
    LAS float* wsf = (LAS float*)(L + L_WS + wave * 256);
    f32x16 O[4];
#pragma unroll
    for (int d = 0; d < 4; ++d) O[d] = (f32x16){};
    float mrun = -1e30f, lrun = 0.f;
    for (int kt = 0; kt < 4; ++kt) {
        f32x16 p[2];
#pragma unroll
        for (int j = 0; j < 2; ++j) { p[j] = (f32x16){}; const int key = 64 * kt + 32 * j + r32;
#pragma unroll
            for (int s = 0; s < 8; ++s) p[j] = __builtin_amdgcn_mfma_f32_32x32x16_bf16(*(const LAS bf16x8*)(L + L_KC + gdn::sw256(key, 2 * s + hi)), qr[s], p[j], 0, 0, 0); }
        float tm = p[0][0];
#pragma unroll
        for (int r = 0; r < 16; ++r) tm = fmaxf(tm, fmaxf(p[0][r], p[1][r]));
        tm = fmaxf(tm, __shfl_xor(tm, 32));
        const float mn = fmaxf(mrun, tm), alpha = __builtin_amdgcn_exp2f(mrun - mn); mrun = mn;
        float ls = 0.f;
#pragma unroll
        for (int j = 0; j < 2; ++j)
#pragma unroll
            for (int r = 0; r < 16; ++r) { p[j][r] = __builtin_amdgcn_exp2f(p[j][r] - mn); ls += p[j][r]; }
        lrun = lrun * alpha + ls;
        if (hi == 0) wsf[r32] = alpha;
        LDS_WAIT(); asm volatile("" ::: "memory");
#pragma unroll
        for (int r = 0; r < 16; ++r) { const float a = wsf[gdn::crow(r, hi)];
#pragma unroll
            for (int d = 0; d < 4; ++d) O[d][r] *= a; }
#pragma unroll
        for (int j = 0; j < 2; ++j)
#pragma unroll
            for (int s = 0; s < 2; ++s) { const bf16x8 af = gdn::packacc(p[j], s); const int c0 = 8 * kt + 4 * j + 2 * s;
#pragma unroll
                for (int d = 0; d < 4; ++d) { const int dv = 32 * d + r32; O[d] = __builtin_amdgcn_mfma_f32_32x32x16_bf16(af, gdn::frag2(L + L_VT, swVT(dv, c0) + 8 * hi, swVT(dv, c0 + 1) + 8 * hi), O[d], 0, 0, 0); } }
        LDS_WAIT(); asm volatile("" ::: "memory");
    }
    lrun += __shfl_xor(lrun, 32);
    if (hi == 0) wsf[32 + r32] = 1.0f / lrun;
    LDS_WAIT(); asm volatile("" ::: "memory");
#pragma unroll
    for (int r = 0; r < 16; ++r) { const int q = gdn::crow(r, hi); const float il = wsf[32 + q];
#pragma unroll
        for (int d = 0; d < 4; ++d) OC[(row0 + q) * 512 + hd * 128 + 32 * d + r32] = (bf16)(pk2r(O[d][r] * il, 0.f) & 0xffffu); }
    __syncthreads();
}
}
#ifndef USE_CG
#define USE_CG 0
#endif
#ifndef PH_LAST
#define PH_LAST 99
#endif
#ifndef TPROBE_W
#define TPROBE_W 4
#endif
__global__ void __launch_bounds__(NWAVES * 64, 2) fwd_megakernel(Args args) {
    extern __shared__ __attribute__((aligned(16))) unsigned char lds[];
    Frame F;
    F.lds = (LAS unsigned char*)lds; F.MISC = (volatile LAS unsigned*)(F.lds + MISC_OFF);
    F.wave = __builtin_amdgcn_readfirstlane((int)threadIdx.x >> 6);
    const bool t0 = (threadIdx.x == 0);
    F.G = gridDim.x; { const int bx = blockIdx.x; F.vcu = (F.G % 8 == 0) ? (bx % 8) * (F.G / 8) + bx / 8 : bx; }
    unsigned char* ws = args.ws; float* dout = args.out;
    F.ctl = (gu32*)(ws + WS_CTL);
    for (int u = F.wave * 64 + lane_id(); u < (LDS_BYTES - LDSCTL_OFF) / 4; u += NWAVES * 64) ((LAS unsigned*)(F.lds + LDSCTL_OFF))[u] = 0u;
    __syncthreads();
#if USE_CG
    cg::grid_group grid = cg::this_grid();
#define GRID_BAR() grid.sync()
#else
    XcdBarrier bar = xcd_barrier_post((unsigned*)(F.ctl + CW_BAR), F.MISC + 8, t0);
#define GRID_BAR() xcd_barrier(bar, F.wave == 0 && lane_id() == 0)
#endif
    const int c = (int)blockIdx.x, G = F.G;
    int n_stamp = 0; unsigned long long* const tsb = (unsigned long long*)(ws + WS_CTL) + 6144;
#define STAMP() do { if (TPROBE >= 0) { if (c == 0 && F.wave == 0 && lane_id() == 0) tsb[n_stamp] = rt(); ++n_stamp; } } while (0)
    STAMP();
    constexpr int NOSPLIT = 1 << 30;
    LAS unsigned char* ring = F.lds;

    p0_prologue(F, args, ws);
    GRID_BAR(); STAMP();
#if PH_LAST >= 1
    for (int mu = c; mu < TOK / 64; mu += G) ab_unit(F, args, ws, mu);
    {   pg8::Gemm g{(const pg8::bf16_t*)(ws + WS_XB), (const pg8::bf16_t*)(ws + WS_W1), TOK, 6144, 1024, NOSPLIT, 0L}; pg8::StaticOrder S; S.init(TOK, 6144, G, c);
        pg8::EpiP1 E{(pg8::bf16_t*)dout, (pg8::bf16_t*)dout + (size_t)TOK * 1024, (pg8::bf16_t*)(ws + WS_VA), (pg8::bf16_t*)(ws + WS_QB), (pg8::bf16_t*)(ws + WS_KB), (pg8::bf16_t*)(ws + WS_VB),
                     (const float*)(ws + WS_RSTD0), (const float*)(ws + WS_RCOS), (const float*)(ws + WS_RSIN), C2Q, (pg8::bf16_t*)(ws + gdn::WS_HALO)};
        pg8::gemm_phase<pg8::EpiP1, pg8::StaticOrder, true, true>(ring, g, S, E, F.wave); }
    GRID_BAR(); STAMP();
#endif
#if PH_LAST >= 2
    gdn::prep_block(F, args, ws, dout, c, G);
    GRID_BAR(); STAMP();
    {
#ifndef NO_GDN
        if (c < 32) { const unsigned long long ts0_ = (TPROBE >= 100) ? rt() : 0ull; gdn::scan_block(F, ws, dout, c >> 3, c & 7); if (TPROBE >= 100 && c == 0 && F.wave == 0 && lane_id() == 0) tsb[16] = rt() - ts0_; }
#endif
        float s1 = 0.f, s2 = 0.f; { const float* q1 = (const float*)args.in[9]; const float* k1 = (const float*)args.in[10]; const float* q2 = (const float*)args.in[11]; const float* k2 = (const float*)args.in[12];
            for (int i = 0; i < 64; ++i) { s1 += q1[i] * k1[i]; s2 += q2[i] * k2[i]; } }
        const float lam = __uint_as_float((unsigned)__builtin_amdgcn_readfirstlane((int)__float_as_uint(expf(s1) - expf(s2) + 0.2f)));
        const attn_body::bf16* QBp = (const attn_body::bf16*)(ws + WS_QB); const attn_body::bf16* KBp = (const attn_body::bf16*)(ws + WS_KB); const attn_body::bf16* VBp = (const attn_body::bf16*)(ws + WS_VB);
#ifndef NO_ATTN
        for (;;) {
            int moff = MISC_OFF + 64; asm volatile("" : "+v"(moff));
            volatile LAS unsigned* qw = (volatile LAS unsigned*)(F.lds + moff);
            if (F.wave == 0 && lane_id() == 0) *qw = __hip_atomic_fetch_add((unsigned*)(F.ctl + CW_QUEUE), 1u, __ATOMIC_RELAXED, __HIP_MEMORY_SCOPE_AGENT);
            __syncthreads(); const unsigned idx = (unsigned)__builtin_amdgcn_readfirstlane((int)*qw); __syncthreads();
            if (idx >= 512u) break;
            const int b = (idx & 31) >> 3, h = idx & 7, qb = 15 - (int)(idx >> 5);
            for (int mode = 0; mode < 4; ++mode)
                attn_body::attn_unit<8>(b, (2 * h + (mode & 1)) * 64, h * 128 + (mode >> 1) * 64, h * 128, qb, mode, lam, QBp, KBp, VBp, (attn_body::bf16*)(ws + WS_QB), (char*)lds, F.wave);
        }
#endif
        (void)lam; (void)QBp; (void)KBp; (void)VBp; }
    GRID_BAR(); STAMP();
#endif
#if PH_LAST >= 3
    {   pg8::Gemm g{(const pg8::bf16_t*)(ws + WS_XB), (const pg8::bf16_t*)(ws + WS_WGZ), TOK, 3072, 1024, NOSPLIT, 0L}; pg8::StaticOrder S; S.init(TOK, 3072, G, c);
        pg8::EpiP3a E{(pg8::bf16_t*)dout, (pg8::bf16_t*)(ws + WS_OA), (const float*)(ws + WS_RSTD0)};
        pg8::gemm_phase<pg8::EpiP3a, pg8::StaticOrder, true, true>(ring, g, S, E, F.wave); }
    GRID_BAR(); STAMP();
    {   pg8::Gemm g{(const pg8::bf16_t*)(ws + WS_OA), (const pg8::bf16_t*)(ws + WS_WOUTA), TOK, 2048, 1024, 4, (long)WS_QB - (long)WS_OA}; pg8::PairOrder S; S.init(TOK, G, c);
        pg8::EpiP3b E{(const pg8::bf16_t*)dout, (pg8::bf16_t*)(ws + WS_MERGED)};
        pg8::gemm_phase<pg8::EpiP3b, pg8::PairOrder, true, true>(ring, g, S, E, F.wave); }
    GRID_BAR(); STAMP();
#endif
#if PH_LAST >= 4
    {   pg8::Gemm g{(const pg8::bf16_t*)(ws + WS_MERGED), (const pg8::bf16_t*)(ws + WS_WO), TOK, 1024, 1024, NOSPLIT, 0L}; pg8::StaticOrder S; S.init(TOK, 1024, G, c);
        pg8::EpiRes E{(const float*)args.in[0], (float*)(ws + WS_X1), (pg8::bf16_t*)(ws + WS_X1B), (float*)(ws + WS_SS1)};
        pg8::gemm_phase<pg8::EpiRes, pg8::StaticOrder, true, true>(ring, g, S, E, F.wave); }
    GRID_BAR(); STAMP();
#endif
#if PH_LAST >= 5
    {   pg8::Gemm g{(const pg8::bf16_t*)(ws + WS_X1B), (const pg8::bf16_t*)(ws + WS_WCQ), TOK, 512, 1024, NOSPLIT, 0L}; pg8::StaticOrder S; S.init(TOK, 512, G, c);
        pg8::EpiRowBf16 E{(pg8::bf16_t*)(ws + WS_QC), 512, nullptr, (const float*)(ws + WS_SS1)};
        pg8::gemm_phase<pg8::EpiRowBf16, pg8::StaticOrder, true, true>(ring, g, S, E, F.wave); }
    {   pg8::Gemm g{(const pg8::bf16_t*)(ws + WS_MEMB), (const pg8::bf16_t*)(ws + WS_WCKV), MEMT, 1024, 1024, NOSPLIT, 0L}; pg8::StaticOrder S; S.init(MEMT, 1024, G, (c + G - (128 % G)) % G);
        pg8::EpiRowBf16 E{(pg8::bf16_t*)(ws + WS_KVC), 1024, (const float*)(ws + WS_RSTDM), nullptr};
        pg8::gemm_phase<pg8::EpiRowBf16, pg8::StaticOrder, true, true>(ring, g, S, E, F.wave); }
    GRID_BAR(); STAMP();
    for (int u = c; u < (TOK / 256) * 4; u += G) xat::unit(F, ws, u >> 2, u & 3);
    GRID_BAR(); STAMP();
#endif
#if PH_LAST >= 6
    {   pg8::Gemm g{(const pg8::bf16_t*)(ws + WS_OC), (const pg8::bf16_t*)(ws + WS_WCO), TOK, 1024, 512, NOSPLIT, 0L}; pg8::StaticOrder S; S.init(TOK, 1024, G, c);
        pg8::EpiRes E{(const float*)(ws + WS_X1), dout, (pg8::bf16_t*)(ws + WS_XB), (float*)(ws + WS_SS2)};
        pg8::gemm_phase<pg8::EpiRes, pg8::StaticOrder, true, true>(ring, g, S, E, F.wave); }
    GRID_BAR(); STAMP();
#endif
#if PH_LAST >= 7
    {   pg8::Gemm g{(const pg8::bf16_t*)(ws + WS_XB), (const pg8::bf16_t*)(ws + WS_WFFI), TOK, 2 * DFF, 1024, NOSPLIT, 0L}; pg8::StaticOrder S; S.init(TOK, 2 * DFF, G, c);
        pg8::EpiAct E{(pg8::bf16_t*)(ws + WS_ACT), (const float*)(ws + WS_SS2)};
        pg8::gemm_phase<pg8::EpiAct, pg8::StaticOrder, true, true>(ring, g, S, E, F.wave); }
    GRID_BAR(); STAMP();
#endif
#if PH_LAST >= 8
    {   pg8::Gemm g{(const pg8::bf16_t*)(ws + WS_ACT), (const pg8::bf16_t*)(ws + WS_WFFO), TOK, 1024, DFF, NOSPLIT, 0L}; pg8::StaticOrder S; S.init(TOK, 1024, G, c);
        pg8::EpiRes E{dout, dout, nullptr, (float*)(ws + WS_SS3)};
        pg8::gemm_phase<pg8::EpiRes, pg8::StaticOrder, true, true>(ring, g, S, E, F.wave); }
    GRID_BAR(); STAMP();
    final_rows(F, dout, (const float*)(ws + WS_SS3), (const float*)args.in[26]);
#endif
    STAMP();
    if (TPROBE >= 0 && c == 0 && F.wave == 0 && lane_id() == 0) { asm volatile("s_waitcnt vmcnt(0)" ::: "memory"); const unsigned long long t0_ = (TPROBE >= 100) ? 0ull : __hip_atomic_load(tsb + (TPROBE % 100), __ATOMIC_RELAXED, __HIP_MEMORY_SCOPE_AGENT), t1_ = (TPROBE >= 100) ? __hip_atomic_load(tsb + 16 + (TPROBE % 100), __ATOMIC_RELAXED, __HIP_MEMORY_SCOPE_AGENT) : __hip_atomic_load(tsb + (TPROBE % 100) + 1, __ATOMIC_RELAXED, __HIP_MEMORY_SCOPE_AGENT);
        const unsigned long long te_ = rt(), dl_ = (t1_ - t0_) * (unsigned long long)TPROBE_W; while (rt() - te_ < dl_) __builtin_amdgcn_s_sleep(32); }
}

extern "C" void kernel_launch(void* const* d_in, const int* in_sizes, int n_in, void* d_out, int out_size, void* d_ws, size_t ws_size, hipStream_t stream) {
    static int grid = 0;
    if (grid == 0) {
        if (n_in != 27 || out_size != TOK * DMODEL || ws_size < WS_END) { fprintf(stderr, "kernel_launch: unexpected problem shape (n_in %d, out %d, ws %zu); nothing launched\n", n_in, out_size, ws_size); grid = -1; return; }
        int dev = 0, cus = 0, per_cu = 0;
        if (hipGetDevice(&dev) != hipSuccess || hipDeviceGetAttribute(&cus, hipDeviceAttributeMultiprocessorCount, dev) != hipSuccess) { grid = -1; return; }
        if (hipFuncSetAttribute((const void*)fwd_megakernel, hipFuncAttributeMaxDynamicSharedMemorySize, LDS_BYTES) != hipSuccess) { fprintf(stderr, "kernel_launch: hipFuncSetAttribute failed\n"); grid = -1; return; }
        if (hipOccupancyMaxActiveBlocksPerMultiprocessor(&per_cu, (const void*)fwd_megakernel, NWAVES * 64, LDS_BYTES) != hipSuccess || per_cu < 1) { fprintf(stderr, "kernel_launch: occupancy query reports %d workgroups per CU\n", per_cu); per_cu = 1; }
        (void)hipGetLastError();
        grid = cus;
        if (grid != 256) fprintf(stderr, "kernel_launch: %d CUs (tuned for 256)\n", grid);
    }
    if (grid < 0) return;
    (void)hipMemsetAsync((char*)d_ws + WS_CTL, 0, CTL_ZERO_BYTES, stream);
    Args a{};
    for (int i = 0; i < 27; ++i) a.in[i] = d_in[i];
    a.out = (float*)d_out; a.ws = (unsigned char*)d_ws;
    for (int i = 0; i < 8; ++i) a.invf[i] = powf(500000.0f, -(float)(2 * i) / 16.0f);
    void* kargs[] = {&a};
    const hipError_t e = hipLaunchCooperativeKernel((const void*)fwd_megakernel, dim3(grid), dim3(NWAVES * 64), kargs, LDS_BYTES, stream);
    if (e != hipSuccess) fprintf(stderr, "kernel_launch: cooperative launch failed: %s (grid %d)\n", hipGetErrorString(e), grid);
}
```
